# Optimizing an MI355X kernel written in HIP

```python
import math
import jax, jax.numpy as jnp
from jax import lax
import numpy as np

D_MODEL = 1024
BATCH = 16
SEQ = 4096
DEPTH = 2

HEAD_DIM = 64
N_Q_HEADS = 16
N_KV_HEADS = 4
GQA_GROUP = N_Q_HEADS // N_KV_HEADS
WINDOW = 128
ATTN_BLOCK = 128
ROPE_THETA = 10000.0
ATT_Q = N_Q_HEADS * HEAD_DIM
ATT_KV = N_KV_HEADS * HEAD_DIM
ATTN_COLS = ATT_Q + 2 * ATT_KV

RWKV_HEAD = 64
RWKV_HEADS = 16
RWKV_DIM = RWKV_HEADS * RWKV_HEAD
DECAY_LORA = 64
AAA_LORA = 64
MV_LORA = 32
GATE_LORA = 128
RWKV_GN_EPS = 64e-5
RWKV_COLS = 3 * RWKV_DIM + DECAY_LORA + AAA_LORA + GATE_LORA

GATE_COLS = 2 * D_MODEL
IN_COLS = ATTN_COLS + RWKV_COLS + GATE_COLS

N_EXPERTS = 32
TOP_K = 4
D_EXPERT = 1024
SWIGLU_LIMIT = 7.0
SWIGLU_ALPHA = 1.702
MOE_BLOCK = 256

LN_EPS = 1e-5
DEEPNORM_ALPHA = (2.0 * DEPTH) ** 0.25
DEEPNORM_BETA = (8.0 * DEPTH) ** -0.25

kernel_name = "hybrid_swa_rwkv7_moe_deepnorm"


def layer_norm(x, g, b):
    xf = x.astype(jnp.float32)
    mu = jnp.mean(xf, axis=-1, keepdims=True)
    var = jnp.mean(jnp.square(xf - mu), axis=-1, keepdims=True)
    return ((xf - mu) * lax.rsqrt(var + LN_EPS)).astype(x.dtype) * g + b


def rope_tables(seq, dtype):
    pos = jnp.arange(seq, dtype=jnp.float32)
    inv = ROPE_THETA ** (-jnp.arange(0, HEAD_DIM, 2, dtype=jnp.float32) / HEAD_DIM)
    ang = pos[:, None] * inv[None, :]
    return jnp.cos(ang)[:, None, :].astype(dtype), jnp.sin(ang)[:, None, :].astype(dtype)


def apply_rope(t, cos, sin):
    t1, t2 = t[..., : HEAD_DIM // 2], t[..., HEAD_DIM // 2:]
    return jnp.concatenate([t1 * cos - t2 * sin, t2 * cos + t1 * sin], axis=-1)


def sliding_window_attention(q, k, v, sinks):
    B, S = q.shape[0], q.shape[1]
    nb = S // ATTN_BLOCK
    qb = q.reshape(B, nb, ATTN_BLOCK, N_KV_HEADS, GQA_GROUP, HEAD_DIM)

    def band(t):
        tb = t.reshape(B, nb, ATTN_BLOCK, N_KV_HEADS, HEAD_DIM)
        prev = jnp.pad(tb[:, :-1], ((0, 0), (1, 0), (0, 0), (0, 0), (0, 0)))
        return jnp.concatenate([prev, tb], axis=2)

    kb, vb = band(k), band(v)
    scores = jnp.einsum('bnqhgd,bnkhd->bnhgqk', qb, kb).astype(jnp.float32) * (HEAD_DIM ** -0.5)
    blk = jnp.arange(nb, dtype=jnp.int32)
    qpos = blk[:, None, None] * ATTN_BLOCK + jnp.arange(ATTN_BLOCK, dtype=jnp.int32)[None, :, None]
    kpos = (blk[:, None, None] - 1) * ATTN_BLOCK + jnp.arange(2 * ATTN_BLOCK, dtype=jnp.int32)[None, None, :]
    diff = qpos - kpos
    valid = (diff >= 0) & (diff < WINDOW) & (kpos >= 0)
    scores = jnp.where(valid[None, :, None, None, :, :], scores, -jnp.inf)
    sink = jnp.broadcast_to(sinks.astype(jnp.float32).reshape(1, 1, N_KV_HEADS, GQA_GROUP, 1, 1),
                            scores.shape[:-1] + (1,))
    probs = jax.nn.softmax(jnp.concatenate([scores, sink], axis=-1), axis=-1)[..., :-1].astype(v.dtype)
    out = jnp.einsum('bnhgqk,bnkhd->bnqhgd', probs, vb)
    return out.reshape(B, S, ATT_Q)


def token_shift(t):
    return jnp.pad(t[:, :-1], ((0, 0), (1, 0), (0, 0)))


def wkv7_scan(r, decay, k, v, a, b):
    B, S, H, N = r.shape
    xs = tuple(jnp.swapaxes(t.astype(jnp.float32), 0, 1) for t in (r, decay, k, v, a, b))

    def step(state, inp):
        r_t, w_t, k_t, v_t, a_t, b_t = inp
        sa = jnp.einsum('bhij,bhj->bhi', state, a_t)
        state = state * w_t[:, :, None, :] + sa[..., None] * b_t[:, :, None, :] + v_t[..., None] * k_t[:, :, None, :]
        return state, jnp.einsum('bhij,bhj->bhi', state, r_t)

    init = jnp.zeros((B, H, N, N), jnp.float32)
    _, out = lax.scan(step, init, xs)
    return jnp.swapaxes(out, 0, 1)


def rwkv7_time_mix(p, mu, w0, w2, a0, a2, g2, k_k, k_a, r_k, lnx_w, lnx_b, w_o, v_first, v_res):
    B, S, _ = p.shape
    p = p + (token_shift(p) - p) * mu
    o1, o2, o3 = RWKV_DIM, 2 * RWKV_DIM, 3 * RWKV_DIM
    o4, o5 = o3 + DECAY_LORA, o3 + DECAY_LORA + AAA_LORA
    r, k, v = p[..., :o1], p[..., o1:o2], p[..., o2:o3]
    wl, al, gl = p[..., o3:o4], p[..., o4:o5], p[..., o5:]
    log_w = -jax.nn.softplus(-(w0 + jnp.tanh(wl) @ w2)) - 0.5
    decay = jnp.exp(-jnp.exp(log_w.astype(jnp.float32)))
    a = jax.nn.sigmoid(a0 + al @ a2)
    g = jax.nn.sigmoid(gl) @ g2
    if v_res is not None:
        v0, v1, v2 = v_res
        v = v + (v_first - v) * jax.nn.sigmoid(v0 + (v @ v1) @ v2)
    heads = lambda t: t.reshape(B, S, RWKV_HEADS, RWKV_HEAD)
    kk = heads(k * k_k).astype(jnp.float32)
    kk = kk / jnp.maximum(jnp.sqrt(jnp.sum(kk * kk, axis=-1, keepdims=True)), 1e-12)
    k = k * (1.0 + (a - 1.0) * k_a)
    rh, kh, vh, ah = heads(r), heads(k), heads(v), heads(a)
    out = wkv7_scan(rh, heads(decay), kh, vh, -kk, kk * ah.astype(jnp.float32))
    mean = jnp.mean(out, axis=-1, keepdims=True)
    var = jnp.mean(jnp.square(out - mean), axis=-1, keepdims=True)
    gn = ((out - mean) * lax.rsqrt(var + RWKV_GN_EPS)).reshape(B, S, RWKV_DIM).astype(p.dtype) * lnx_w + lnx_b
    bonus = (jnp.sum(rh * kh * r_k, axis=-1, keepdims=True) * vh).reshape(B, S, RWKV_DIM)
    return ((gn + bonus) * g) @ w_o, v


def moe_ffn(x, router_w, router_b, w1, b1, w2, b2):
    B, S, D = x.shape
    T = B * S
    A = T * TOP_K
    xf = x.reshape(T, D)
    logits = (xf @ router_w + router_b).astype(jnp.float32)
    top_vals, top_idx = lax.top_k(logits, TOP_K)
    gates = jax.nn.softmax(top_vals, axis=-1)
    e_flat = top_idx.reshape(A).astype(jnp.int32)
    tok_flat = jnp.broadcast_to(jnp.arange(T, dtype=jnp.int32)[:, None], (T, TOP_K)).reshape(A)
    gate_flat = gates.reshape(A)
    order = jnp.argsort(e_flat)
    e_sorted = e_flat[order]
    counts = jnp.bincount(e_flat, length=N_EXPERTS).astype(jnp.int32)
    starts = jnp.cumsum(counts) - counts
    padded = ((counts + MOE_BLOCK - 1) // MOE_BLOCK) * MOE_BLOCK
    pend = jnp.cumsum(padded)
    pstart = pend - padded
    dest = pstart[e_sorted] + (jnp.arange(A, dtype=jnp.int32) - starts[e_sorted])
    n_blocks = -(-A // MOE_BLOCK) + N_EXPERTS
    P = n_blocks * MOE_BLOCK
    row_tok = jnp.zeros((P,), jnp.int32).at[dest].set(tok_flat[order])
    row_gate = jnp.zeros((P,), x.dtype).at[dest].set(gate_flat[order].astype(x.dtype))
    block_start = jnp.arange(n_blocks, dtype=jnp.int32) * MOE_BLOCK
    block_exp = jnp.minimum(jnp.searchsorted(pend, block_start, side='right'), N_EXPERTS - 1).astype(jnp.int32)

    def expert_block(args):
        tok, gate, e = args
        h = xf[tok] @ w1[e] + b1[e]
        x_glu = jnp.minimum(h[:, ::2], SWIGLU_LIMIT)
        x_lin = jnp.clip(h[:, 1::2], -SWIGLU_LIMIT, SWIGLU_LIMIT)
        act = x_glu * jax.nn.sigmoid(SWIGLU_ALPHA * x_glu) * (x_lin + 1.0)
        return (act @ w2[e] + b2[e]) * gate[:, None]

    out = lax.map(expert_block, (row_tok.reshape(n_blocks, MOE_BLOCK), row_gate.reshape(n_blocks, MOE_BLOCK), block_exp))
    y = jax.ops.segment_sum(out.reshape(P, D), row_tok, num_segments=T)
    return y.reshape(B, S, D)


def setup_inputs(seed: int = 0) -> dict:
    key = jax.random.key(seed)
    ks = iter(jax.random.split(key, 40))
    nrm = lambda shape, scale: jax.random.normal(next(ks), shape, jnp.float32) * scale
    uni = lambda shape, lo, hi: jax.random.uniform(next(ks), shape, jnp.float32, lo, hi)
    L, D, Dr, E, I = DEPTH, D_MODEL, RWKV_DIM, N_EXPERTS, D_EXPERT
    Lv = max(DEPTH - 1, 0)
    return {
        "x": nrm((BATCH, SEQ, D), 1.0),
        "w_in": nrm((L, D, IN_COLS), D ** -0.5),
        "attn_sinks": nrm((L, N_Q_HEADS), 0.5),
        "w_attn_o": nrm((L, ATT_Q, D), ATT_Q ** -0.5),
        "rwkv_mu": uni((L, RWKV_COLS), 0.0, 1.0),
        "rwkv_w0": uni((L, Dr), -6.0, -1.0),
        "rwkv_w2": nrm((L, DECAY_LORA, Dr), 0.5 * DECAY_LORA ** -0.5),
        "rwkv_a0": nrm((L, Dr), 0.1),
        "rwkv_a2": nrm((L, AAA_LORA, Dr), 0.5 * AAA_LORA ** -0.5),
        "rwkv_g2": nrm((L, GATE_LORA, Dr), GATE_LORA ** -0.5),
        "rwkv_k_k": 0.85 + nrm((L, Dr), 0.05),
        "rwkv_k_a": 1.0 + nrm((L, Dr), 0.05),
        "rwkv_r_k": nrm((L, RWKV_HEADS, RWKV_HEAD), 0.1),
        "rwkv_v0": 1.0 + nrm((Lv, Dr), 0.1),
        "rwkv_v1": nrm((Lv, Dr, MV_LORA), Dr ** -0.5),
        "rwkv_v2": nrm((Lv, MV_LORA, Dr), 0.5 * MV_LORA ** -0.5),
        "rwkv_lnx_w": 1.0 + nrm((L, Dr), 0.1),
        "rwkv_lnx_b": nrm((L, Dr), 0.01),
        "w_rwkv_o": nrm((L, Dr, D), Dr ** -0.5),
        "w_out": nrm((L, D, D), DEEPNORM_BETA * D ** -0.5),
        "ln1_g": 1.0 + nrm((L, D), 0.1),
        "ln1_b": nrm((L, D), 0.01),
        "router_w": nrm((L, D, E), D ** -0.5),
        "router_b": nrm((L, E), 0.01),
        "expert_w1": nrm((L, E, D, 2 * I), D ** -0.5),
        "expert_b1": nrm((L, E, 2 * I), 0.01),
        "expert_w2": nrm((L, E, I, D), DEEPNORM_BETA * I ** -0.5),
        "expert_b2": nrm((L, E, D), 0.01),
        "ln2_g": 1.0 + nrm((L, D), 0.1),
        "ln2_b": nrm((L, D), 0.01),
    }


def reference(x, w_in, attn_sinks, w_attn_o, rwkv_mu, rwkv_w0, rwkv_w2, rwkv_a0, rwkv_a2, rwkv_g2,
              rwkv_k_k, rwkv_k_a, rwkv_r_k, rwkv_v0, rwkv_v1, rwkv_v2, rwkv_lnx_w, rwkv_lnx_b, w_rwkv_o,
              w_out, ln1_g, ln1_b, router_w, router_b, expert_w1, expert_b1, expert_w2, expert_b2,
              ln2_g, ln2_b):
    B, S, D = x.shape
    cos, sin = rope_tables(S, x.dtype)
    v_first = None
    for l in range(DEPTH):
        p = x @ w_in[l]
        q = p[..., :ATT_Q].reshape(B, S, N_Q_HEADS, HEAD_DIM)
        k = p[..., ATT_Q:ATT_Q + ATT_KV].reshape(B, S, N_KV_HEADS, HEAD_DIM)
        v = p[..., ATT_Q + ATT_KV:ATTN_COLS].reshape(B, S, N_KV_HEADS, HEAD_DIM)
        p_rwkv = p[..., ATTN_COLS:ATTN_COLS + RWKV_COLS]
        gate_attn = jax.nn.sigmoid(p[..., ATTN_COLS + RWKV_COLS:ATTN_COLS + RWKV_COLS + D])
        gate_rwkv = jax.nn.sigmoid(p[..., ATTN_COLS + RWKV_COLS + D:])

        y_attn = sliding_window_attention(apply_rope(q, cos, sin), apply_rope(k, cos, sin), v, attn_sinks[l]) @ w_attn_o[l]

        v_res = None if l == 0 else (rwkv_v0[l - 1], rwkv_v1[l - 1], rwkv_v2[l - 1])
        y_rwkv, v_l = rwkv7_time_mix(p_rwkv, rwkv_mu[l], rwkv_w0[l], rwkv_w2[l], rwkv_a0[l], rwkv_a2[l],
                                     rwkv_g2[l], rwkv_k_k[l], rwkv_k_a[l], rwkv_r_k[l], rwkv_lnx_w[l],
                                     rwkv_lnx_b[l], w_rwkv_o[l], v_first, v_res)
        if l == 0:
            v_first = v_l

        mixed = (gate_attn * y_attn + gate_rwkv * y_rwkv) @ w_out[l]
        x = layer_norm(DEEPNORM_ALPHA * x + mixed, ln1_g[l], ln1_b[l])

        ffn = moe_ffn(x, router_w[l], router_b[l], expert_w1[l], expert_b1[l], expert_w2[l], expert_b2[l])
        x = layer_norm(DEEPNORM_ALPHA * x + ffn, ln2_g[l], ln2_b[l])
    return x
```

```cpp
#include <hip/hip_runtime.h>
#include <cstdio>
#include <cstdint>
#include <type_traits>

#ifndef MK_ONE_LAUNCH
#define MK_ONE_LAUNCH 1
#endif

#define LAS __attribute__((address_space(3)))
#define GAS __attribute__((address_space(1)))
typedef unsigned short bf16;
typedef short bf16x8 __attribute__((ext_vector_type(8)));
typedef short s16x4 __attribute__((ext_vector_type(4)));
typedef float f32x2 __attribute__((ext_vector_type(2)));
typedef float f32x4 __attribute__((ext_vector_type(4)));
typedef float f32x16 __attribute__((ext_vector_type(16)));
typedef unsigned u32x2 __attribute__((ext_vector_type(2)));
typedef unsigned u32x4 __attribute__((ext_vector_type(4)));
typedef __bf16 bf16x2_t __attribute__((ext_vector_type(2)));
typedef GAS unsigned gu32;
#define RLX_AGENT __ATOMIC_RELAXED, __HIP_MEMORY_SCOPE_AGENT
#define DI __device__ __forceinline__

constexpr int BATCH = 16, SEQ = 4096, T = BATCH * SEQ, D = 1024, DEPTH = 2;
constexpr int NQH = 16, NKVH = 4, HD = 64;
constexpr int IN_COLS = 6912, RWKV_COLS = 3328;
constexpr int C_Q = 0, C_K = 1024, C_V = 1280, C_R = 1536, C_RK = 2560, C_RV = 3584, C_WL = 4608, C_AL = 4672, C_GL = 4736, C_GA = 4864, C_GR = 5888;
constexpr int NE = 32, DE = 1024;
constexpr float LN_EPS = 1e-5f, GN_EPS = 64e-5f;
constexpr float ALPHA = 1.41421356237f;
constexpr int MAXTILES = 1056;

constexpr size_t MiB = 1u << 20;
constexpr size_t WS_CTL = 0, CTL_ZERO_BYTES = 1 * MiB;
constexpr size_t WS_ROPE = 1 * MiB;
constexpr size_t WS_WIN = 2 * MiB;
constexpr size_t WS_WAO = 16 * MiB, WS_WRO = 18 * MiB, WS_WOUT = 20 * MiB;
constexpr size_t WS_LORA = 22 * MiB;
constexpr size_t LO_W2 = 0, LO_A2 = 131072, LO_G2 = 262144, LO_V2 = 524288, LO_V1 = 589824;
constexpr size_t WS_W1 = 24 * MiB;
constexpr size_t WS_M8 = 88 * MiB;
constexpr size_t WS_W2 = 152 * MiB;
constexpr size_t WS_XB = 216 * MiB;
constexpr size_t WS_VF = 344 * MiB;
constexpr size_t WS_RWO = 472 * MiB;
constexpr size_t WS_M = 600 * MiB;
constexpr size_t WS_VL = 728 * MiB;
constexpr size_t WS_TOKINFO = 736 * MiB;
constexpr size_t WS_GATE = 737 * MiB;
constexpr size_t WS_TOKLIST = 738 * MiB;
constexpr size_t WS_STAT = 747 * MiB;
constexpr size_t WS_RIMG = 746 * MiB;
constexpr size_t WS_R = 752 * MiB;
constexpr size_t WS_ACT = WS_R, WS_YS = WS_R + 528 * MiB;
constexpr size_t WS_XB8 = WS_R + 1056 * MiB;
constexpr size_t WS_XI8 = WS_XB8 + 64 * MiB;
constexpr size_t WS_LI = WS_XI8 + 64 * MiB;
constexpr size_t WS_ATT8 = WS_LI + 32 * MiB;
constexpr size_t WS_END = WS_ATT8 + 64 * MiB;
static_assert((size_t)T * IN_COLS * 2 <= 864 * MiB && (size_t)MAXTILES * 256 * 1024 * 2 <= 528 * MiB, "region R");
constexpr int CW_TMO = 0;
constexpr int CW_BAR = 4096;
constexpr int CW_CNT = 16384;

constexpr int LDS_BYTES = 163840;
constexpr int LDSCTL_OFF = 155648;
constexpr int L_MISC = LDSCTL_OFF;
constexpr int L_BARST = LDS_BYTES - 64;
constexpr int L_CNT = LDSCTL_OFF + 256;
constexpr int L_BASE = LDSCTL_OFF + 384;
constexpr int L_TSTART = LDSCTL_OFF + 512;
constexpr int L_ASG = LDSCTL_OFF + 1024;
constexpr int L_LG = LDSCTL_OFF + 1024 + 4096;
static_assert(L_LG + 1024 <= L_BARST, "LDS map");

DI float bf2f(unsigned short b) { return __uint_as_float(((unsigned)b) << 16); }
DI unsigned f2bf(float f) { unsigned u = __float_as_uint(f); return (u + 0x7fffu + ((u >> 16) & 1u)) >> 16; }
DI unsigned pk2(float lo, float hi) { f32x2 v = {lo, hi}; bf16x2_t b = __builtin_convertvector(v, bf16x2_t); return __builtin_bit_cast(unsigned, b); }
DI unsigned pk4_fp8(float a, float b, float c, float d) { int w = 0; w = __builtin_amdgcn_cvt_pk_fp8_f32(a, b, w, false); w = __builtin_amdgcn_cvt_pk_fp8_f32(c, d, w, true); return (unsigned)w; }
DI unsigned short bf1(float x) { return (unsigned short)pk2(x, x); }
DI float bflo(unsigned w) { return __uint_as_float(w << 16); }
DI float bfhi(unsigned w) { return __uint_as_float(w & 0xffff0000u); }
#define DPP_ADD_(v, ctrl, rm) v += __builtin_bit_cast(float, __builtin_amdgcn_update_dpp(0, __builtin_bit_cast(int, v), ctrl, rm, 0xf, false))
DI float wave_sum(float v) {
    DPP_ADD_(v, 0x111, 0xf); DPP_ADD_(v, 0x112, 0xf); DPP_ADD_(v, 0x114, 0xf); DPP_ADD_(v, 0x118, 0xf); DPP_ADD_(v, 0x142, 0xa); DPP_ADD_(v, 0x143, 0xc);
    return __builtin_bit_cast(float, __builtin_amdgcn_readlane(__builtin_bit_cast(int, v), 63));
}
DI float tanh_fast(float x) { const float e = __expf(2.0f * x); return 1.0f - 2.0f * __builtin_amdgcn_rcpf(e + 1.0f); }
DI float shx(float v, int mask, int lane) { return __builtin_bit_cast(float, __builtin_amdgcn_ds_bpermute((lane ^ mask) << 2, __builtin_bit_cast(int, v))); }
DI float shl(float v, int src) { return __builtin_bit_cast(float, __builtin_amdgcn_ds_bpermute(src << 2, __builtin_bit_cast(int, v))); }
DI float sigmoidf_(float x) { return __builtin_amdgcn_rcpf(1.0f + __expf(-x)); }
DI f32x2 sigmoid2_l2(f32x2 xl) { f32x2 e = {__builtin_amdgcn_exp2f(xl[0]), __builtin_amdgcn_exp2f(xl[1])}; e = e + 1.0f; return (f32x2){__builtin_amdgcn_rcpf(e[0]), __builtin_amdgcn_rcpf(e[1])}; }

#define XB_TMO      128
#define XB_XCNT(j)  (256  + 64 * (j))
#define XB_XSUB(j)  (1280 + 64 * (j))
#define XB_XGEN(j)  (2304 + 64 * (j))
#define XB_TOP      3328
#define XB_TOPGEN   3392
#define XCD_BAR_WORDS 3456
#define XB_SPIN_CAP (1u << 18)
DI unsigned xb_ld(unsigned* p)              { return __hip_atomic_load(p, __ATOMIC_RELAXED, __HIP_MEMORY_SCOPE_AGENT); }
DI unsigned xb_add(unsigned* p, unsigned v) { return __hip_atomic_fetch_add(p, v, __ATOMIC_RELAXED, __HIP_MEMORY_SCOPE_AGENT); }
DI unsigned xb_xcc_id() { return (unsigned)__builtin_amdgcn_s_getreg((3 << 11) | 20) & 0xFu; }
#define XB_SPIN(cond, bar) do { unsigned _sp = 0; while (cond) { __builtin_amdgcn_s_sleep(1); \
    if ((++_sp & 255u) == 0u) { if (xb_ld(&(bar)[XB_TMO])) break; if (_sp > XB_SPIN_CAP) { atomicAdd(&(bar)[XB_TMO], 1u); break; } } } } while (0)
struct XcdBarrier { unsigned* bar; unsigned x; volatile LAS unsigned* st; };
DI bool xb_leader(int wave) { unsigned z_ = 0u; asm volatile("" : "+v"(z_)); return wave == 0 && __builtin_amdgcn_mbcnt_hi(~0u, __builtin_amdgcn_mbcnt_lo(~0u, z_)) == 0u; }
DI XcdBarrier xcd_barrier_post(unsigned* bar, volatile LAS unsigned* st, int wave) {
    XcdBarrier b; b.bar = bar; b.x = xb_xcc_id(); b.st = st;
    if (xb_leader(wave)) (void)xb_add(&bar[XB_XCNT(b.x)], 1u);
    return b;
}
DI void xcd_barrier_complete(unsigned* bar, unsigned x, unsigned& nloc, unsigned& nx) {
    const unsigned G = gridDim.x * gridDim.y * gridDim.z;
    unsigned sum, cnt, mine, sp = 0u;
    for (;;) {
        sum = 0u; cnt = 0u; mine = 0u;
#pragma unroll
        for (unsigned j = 0; j < 16; ++j) { const unsigned c = xb_ld(&bar[XB_XCNT(j)]); sum += c; cnt += (c > 0u) ? 1u : 0u; mine = (j == x) ? c : mine; }
        if (sum == G) break;
        __builtin_amdgcn_s_sleep(1);
        if ((++sp & 255u) == 0u) { if (xb_ld(&bar[XB_TMO])) break; if (sp > XB_SPIN_CAP) { atomicAdd(&bar[XB_TMO], 1u); break; } }
    }
    nloc = mine > 0u ? mine : 1u; nx = cnt > 0u ? cnt : 1u;
}
DI void xcd_barrier(const XcdBarrier& b, int wave) {
    asm volatile("s_waitcnt vmcnt(0)" ::: "memory");
    __syncthreads();
    if (xb_leader(wave)) {
        unsigned* bar = b.bar; asm volatile("" : "+s"(bar));
        __builtin_amdgcn_s_waitcnt(0);
        unsigned nloc = b.st[0], nx = b.st[1];
        if (nloc == 0u) { xcd_barrier_complete(bar, b.x, nloc, nx); b.st[0] = nloc; b.st[1] = nx; }
        const unsigned old = xb_add(&bar[XB_XSUB(b.x)], 1u);
        const unsigned gen = old / nloc;
        if (old + 1u == (gen + 1u) * nloc) {
            __builtin_amdgcn_fence(__ATOMIC_RELEASE, "agent");
            asm volatile("s_waitcnt vmcnt(0)" ::: "memory");
            const unsigned og = xb_add(&bar[XB_TOP], 1u);
            const unsigned tg = og / nx;
            if (og + 1u == (tg + 1u) * nx) xb_add(&bar[XB_TOPGEN], 1u);
            else XB_SPIN(xb_ld(&bar[XB_TOPGEN]) == tg, bar);
            __builtin_amdgcn_fence(__ATOMIC_ACQUIRE, "agent");
            xb_add(&bar[XB_XGEN(b.x)], 1u);
            asm volatile("s_waitcnt vmcnt(0)" ::: "memory");
        } else {
            XB_SPIN(xb_ld(&bar[XB_XGEN(b.x)]) == gen, bar);
            __builtin_amdgcn_fence(__ATOMIC_ACQUIRE, "agent");
            asm volatile("s_waitcnt vmcnt(0)" ::: "memory");
        }
    }
    __syncthreads();
}

namespace pg8 {
constexpr int BM = 256, BK = 64, HALF = 128, HTB = HALF * BK * 2, STAGE_BYTES = 8 * HTB, NXCD = 8, WGM = 8;
DI int lds_byte(int r, int c) { const int st = (r >> 4) * 2 + (c >> 5), rr = r & 15, cc = c & 31, ob = rr * 64 + cc * 2; return st * 1024 + (ob ^ (((ob >> 9) & 1) << 5)); }
DI void stage_rc(int b, int& R, int& C) { const int st = b / 1024, sb = b % 1024, swz = sb ^ (((sb >> 9) & 1) << 5); R = (st >> 1) * 16 + swz / 64; C = (st & 1) * 32 + (swz % 64) / 2; }
DI int perm32(int rho) { const int n = rho >> 4, i = rho & 15; return 8 * (i >> 2) + 4 * n + (i & 3); }

struct Unit { int pm, pn, e, r0; };

struct DenseSched {
    const bf16* A; const bf16* Bt; int lda, K; int nM, nN, nwg, G, c; int eb, sA, sB;
    DI void init(const bf16* A_, int lda_, const bf16* Bt_, int M, int N, int K_, int G_, int c_, int eb_ = 2, int sA_ = 0x7F7F7F7F, int sB_ = 0x7F7F7F7F) { A = A_; lda = lda_; Bt = Bt_; K = K_; nM = M / BM; nN = N / BM; nwg = nM * nN; G = G_; c = c_; eb = eb_; sA = sA_; sB = sB_; }
    DI bool next(int i, Unit& u) const {
        const long L = (long)i * G + c; if (L >= nwg) return false;
        int wgid = (int)L; { const int q = nwg / NXCD, r = nwg % NXCD, xcd = wgid % NXCD, off = wgid / NXCD; wgid = (xcd < r ? xcd * (q + 1) : r * (q + 1) + (xcd - r) * q) + off; }
        const int nig = WGM * nN, gid = wgid / nig, fm = gid * WGM, gsz = (nM - fm) < WGM ? (nM - fm) : WGM;
        u.pm = fm + ((wgid % nig) % gsz); u.pn = (wgid % nig) / gsz; u.e = 0; u.r0 = 0; return true;
    }
    DI const char* a_base(const Unit& u) const { return (const char*)A + (size_t)u.pm * BM * lda * eb; }
    DI const char* b_base(const Unit& u) const { return (const char*)Bt + (size_t)u.pn * BM * K * eb; }
    DI unsigned a_row_off(const Unit&, int r) const { return (unsigned)r * (unsigned)lda * (unsigned)eb; }
};
struct MoeSched {
    const bf16* A; const bf16* Bt; int lda, K; int npn, NT, nwg, G, c; size_t bexp  ;
    const LAS int* tstart; const LAS int* cnt; const int* toklist; bool gather; int eb  ; int sA, sB  ;
    DI bool next(int i, Unit& u) const {
        const long L = (long)i * G + c; if (L >= nwg) return false;
        int wgid = (int)L; { const int q = nwg / NXCD, r = nwg % NXCD, xcd = wgid % NXCD, off = wgid / NXCD; wgid = (xcd < r ? xcd * (q + 1) : r * (q + 1) + (xcd - r) * q) + off; }
        wgid = __builtin_amdgcn_readfirstlane(wgid);
        const int rt = wgid / npn; u.pn = wgid % npn; u.pm = rt;
        unsigned z_ = 0u; asm volatile("" : "+v"(z_)); const int ln = (int)__builtin_amdgcn_mbcnt_hi(~0u, __builtin_amdgcn_mbcnt_lo(~0u, z_));
        const bool hit = (ln >= 1 && ln < NE) && (tstart[ln & 31] <= rt);
        const int e = __builtin_popcountll(__ballot(hit));
        u.e = e; u.r0 = (rt - tstart[e]) * BM; return true;
    }
    DI const char* a_base(const Unit& u) const { return gather ? (const char*)A : (const char*)A + (size_t)u.pm * BM * lda * eb; }
    DI const char* b_base(const Unit& u) const { return (const char*)Bt + (size_t)u.e * bexp + (size_t)u.pn * BM * K * eb; }
    DI unsigned a_row_off(const Unit& u, int r) const {
        if (!gather) return (unsigned)r * (unsigned)lda * (unsigned)eb;
        const int ce = cnt[u.e]; int idx = u.r0 + r; idx = idx < ce ? idx : u.r0;
        const int tok = toklist[(size_t)u.e * T + idx];
        return (unsigned)tok * (unsigned)lda * (unsigned)eb;
    }
};

DI unsigned cvt_pk_bf16(float lo, float hi) { return pk2(lo, hi); }
typedef int v4i_ __attribute__((ext_vector_type(4)));
typedef int v8i_ __attribute__((ext_vector_type(8)));
DI v8i_ cat8(bf16x8 a, bf16x8 b) { return __builtin_shufflevector(__builtin_bit_cast(v4i_, a), __builtin_bit_cast(v4i_, b), 0, 1, 2, 3, 4, 5, 6, 7); }

template <class Epi, class Sched, bool GATHER, bool FP8 = false>
DI void gemm_phase(LAS unsigned char* lds, const int tid, const Sched& S, const Epi& E) {
    const int wid = __builtin_amdgcn_readfirstlane(tid >> 6), lane = tid & 63, wr = wid >> 2, wc = wid & 3, fr = lane & 15, fq = lane >> 4;
    const int K = S.K, EB = FP8 ? 1 : 2, nt = FP8 ? K / 128 : K / BK, lda = S.lda;
    unsigned voffB[2]; int Rr[2], Cc[2];
#pragma unroll
    for (int i = 0; i < 2; ++i) { int R, C; stage_rc(tid * 16 + i * 8192, R, C); const int Rb = Epi::PERM ? ((R & ~31) + perm32(R & 31)) : R;
        Rr[i] = R; Cc[i] = C; voffB[i] = (unsigned)(Rb * K * EB + C * 2); }
    const size_t kstep = (size_t)(BK * 2);
    const int sclA = S.sA, sclB = S.sB;
    const size_t hstepB = (size_t)HALF * K * EB;
    const unsigned ldsw = (unsigned)wid * 1024u;
    const int aoff = lds_byte(wr * 64 + fr, fq * 8), boff = lds_byte(wc * 32 + fr, fq * 8);
#define PG8_SA(b, h) (((b) * 2 + (h)) * HTB)
#define PG8_SB(b, h) ((4 + (b) * 2 + (h)) * HTB)
#define PG8_STAGE_B(bufoff, gbase) do { _Pragma("unroll") for (int _i = 0; _i < 2; ++_i) \
        __builtin_amdgcn_global_load_lds((const unsigned*)((const char*)(gbase) + voffB[_i]), (LAS unsigned*)(lds + (bufoff) + ldsw + _i * 8192), 16, 0, 0); } while (0)
#define PG8_STAGE_A(bufoff, gbase, o0, o1) do { \
        __builtin_amdgcn_global_load_lds((const unsigned*)((const char*)(gbase) + (o0)), (LAS unsigned*)(lds + (bufoff) + ldsw), 16, 0, 0); \
        __builtin_amdgcn_global_load_lds((const unsigned*)((const char*)(gbase) + (o1)), (LAS unsigned*)(lds + (bufoff) + ldsw + 8192), 16, 0, 0); } while (0)
#define PG8_LDA(dst, b, h) do { _Pragma("unroll") for (int m = 0; m < 4; ++m) _Pragma("unroll") for (int k = 0; k < 2; ++k) dst[m][k] = *(const LAS bf16x8*)(lds + PG8_SA(b, h) + aoff + m * 2048 + k * 1024); } while (0)
#define PG8_LDB(dst, b, h) do { _Pragma("unroll") for (int n = 0; n < 2; ++n) _Pragma("unroll") for (int k = 0; k < 2; ++k) dst[n][k] = *(const LAS bf16x8*)(lds + PG8_SB(b, h) + boff + n * 2048 + k * 1024); } while (0)
#define PG8_MMA(ai, bj, At, Bt) do { __builtin_amdgcn_s_setprio(1); \
        if constexpr (FP8) { _Pragma("unroll") for (int m = 0; m < 4; ++m) _Pragma("unroll") for (int n = 0; n < 2; ++n) \
            asm volatile("v_mfma_scale_f32_16x16x128_f8f6f4 %0, %1, %2, %0, %3, %4 op_sel_hi:[0,0,0]" : "+v"(acc[ai][bj][m][n]) : "v"(cat8(Bt[n][0], Bt[n][1])), "v"(cat8(At[m][0], At[m][1])), "v"(sclB), "v"(sclA)); } \
        else { _Pragma("unroll") for (int m = 0; m < 4; ++m) _Pragma("unroll") for (int n = 0; n < 2; ++n) _Pragma("unroll") for (int k = 0; k < 2; ++k) \
            acc[ai][bj][m][n] = __builtin_amdgcn_mfma_f32_16x16x32_bf16(Bt[n][k], At[m][k], acc[ai][bj][m][n], 0, 0, 0); } \
        __builtin_amdgcn_s_setprio(0); } while (0)
#define PG8_WAIT_V(n) asm volatile("s_waitcnt vmcnt(" #n ")" ::: "memory")
#define PG8_WAIT_L(n) asm volatile("s_waitcnt lgkmcnt(" #n ")" ::: "memory")
#define PG8_BAR __builtin_amdgcn_s_barrier()
#define PG8_SCHED __builtin_amdgcn_sched_barrier(0)
    Unit cur, nxt; int ui = 0;
    if (!S.next(0, cur)) return;
    f32x4 acc[2][2][4][2];
#pragma unroll
    for (int a = 0; a < 2; ++a)
#pragma unroll
        for (int b = 0; b < 2; ++b)
#pragma unroll
            for (int m = 0; m < 4; ++m)
#pragma unroll
                for (int n = 0; n < 2; ++n) acc[a][b][m][n] = (f32x4){0.f, 0.f, 0.f, 0.f};
    bf16x8 At[4][2], B0[2][2], B1[2][2];
    unsigned avC[2][2], avN[2][2];
#pragma unroll
    for (int hh = 0; hh < 2; ++hh)
#pragma unroll
        for (int i = 0; i < 2; ++i) { avC[hh][i] = S.a_row_off(cur, hh * HALF + Rr[i]) + (unsigned)Cc[i] * 2u; avN[hh][i] = avC[hh][i]; }
    const char* cA = S.a_base(cur); const char* cB = S.b_base(cur);
    PG8_STAGE_B(PG8_SB(0, 0), cB); PG8_STAGE_B(PG8_SB(0, 1), cB + hstepB); PG8_STAGE_A(PG8_SA(0, 0), cA, avC[0][0], avC[0][1]); PG8_STAGE_A(PG8_SA(0, 1), cA, avC[1][0], avC[1][1]);
    if (wr == 1) PG8_BAR;
    PG8_WAIT_V(2); PG8_BAR;
    PG8_STAGE_B(PG8_SB(1, 0), cB + kstep); PG8_STAGE_A(PG8_SA(1, 0), cA + kstep, avC[0][0], avC[0][1]); PG8_STAGE_B(PG8_SB(1, 1), cB + hstepB + kstep);
    PG8_WAIT_V(6); PG8_BAR;
    for (;;) {
        const bool has_next = S.next(ui + 1, nxt);
        const char* nA = has_next ? S.a_base(nxt) : cA; const char* nB = has_next ? S.b_base(nxt) : cB;
        if (GATHER) {
#pragma unroll
            for (int hh = 0; hh < 2; ++hh)
#pragma unroll
                for (int i = 0; i < 2; ++i) avN[hh][i] = has_next ? (S.a_row_off(nxt, hh * HALF + Rr[i]) + (unsigned)Cc[i] * 2u) : avC[hh][i];
        }
        for (int t = 0; t < nt; t += 2) {
            const bool last = (t == nt - 2);
            const char* a1 = cA + (size_t)(t + 1) * kstep;
            const char* a2 = last ? nA : cA + (size_t)(t + 2) * kstep; const char* b2 = last ? nB : cB + (size_t)(t + 2) * kstep;
            const char* a3 = a2 + kstep; const char* b3 = b2 + kstep;
            unsigned x00 = avC[0][0], x01 = avC[0][1], x10 = avC[1][0], x11 = avC[1][1];
            if (GATHER) { x00 = last ? avN[0][0] : x00; x01 = last ? avN[0][1] : x01; x10 = last ? avN[1][0] : x10; x11 = last ? avN[1][1] : x11; }
            PG8_LDB(B0, 0, 0); PG8_LDB(B1, 0, 1); PG8_SCHED; PG8_LDA(At, 0, 0); PG8_STAGE_A(PG8_SA(1, 1), a1, avC[1][0], avC[1][1]);
            PG8_WAIT_V(8); PG8_WAIT_L(0); PG8_BAR; PG8_MMA(0, 0, At, B0); PG8_MMA(0, 1, At, B1); PG8_BAR; PG8_SCHED;
            PG8_LDA(At, 0, 1); PG8_STAGE_B(PG8_SB(0, 0), b2); PG8_STAGE_B(PG8_SB(0, 1), b2 + hstepB); PG8_STAGE_A(PG8_SA(0, 0), a2, x00, x01);
            PG8_WAIT_V(8); PG8_WAIT_L(0); PG8_BAR; PG8_MMA(1, 0, At, B0); PG8_MMA(1, 1, At, B1); PG8_BAR; PG8_SCHED;
            PG8_LDB(B0, 1, 0); PG8_LDB(B1, 1, 1); PG8_SCHED; PG8_LDA(At, 1, 0); PG8_STAGE_A(PG8_SA(0, 1), a2, x10, x11);
            PG8_WAIT_V(8); PG8_WAIT_L(0); PG8_BAR; PG8_MMA(0, 0, At, B0); PG8_MMA(0, 1, At, B1); PG8_BAR; PG8_SCHED;
            PG8_LDA(At, 1, 1); PG8_STAGE_B(PG8_SB(1, 0), b3); PG8_STAGE_B(PG8_SB(1, 1), b3 + hstepB); PG8_STAGE_A(PG8_SA(1, 0), a3, x00, x01);
            PG8_WAIT_V(8); PG8_WAIT_L(0); PG8_BAR; PG8_MMA(1, 0, At, B0); PG8_MMA(1, 1, At, B1); PG8_BAR; PG8_SCHED;
        }
        if (wr == 0) PG8_BAR;
        E(acc, cur, wr, wc, fr, fq);
        if (!has_next) break;
#pragma unroll
        for (int a = 0; a < 2; ++a)
#pragma unroll
            for (int b = 0; b < 2; ++b)
#pragma unroll
                for (int m = 0; m < 4; ++m)
#pragma unroll
                    for (int n = 0; n < 2; ++n) acc[a][b][m][n] = (f32x4){0.f, 0.f, 0.f, 0.f};
        cur = nxt; cA = nA; cB = nB; ++ui;
        if (GATHER) {
#pragma unroll
            for (int hh = 0; hh < 2; ++hh)
#pragma unroll
                for (int i = 0; i < 2; ++i) avC[hh][i] = avN[hh][i];
        }
        if (wr == 1) PG8_BAR;
    }
    PG8_WAIT_V(0);
    PG8_BAR;
#undef PG8_SA
#undef PG8_SB
#undef PG8_STAGE_A
#undef PG8_STAGE_B
#undef PG8_LDA
#undef PG8_LDB
#undef PG8_MMA
#undef PG8_WAIT_V
#undef PG8_WAIT_L
#undef PG8_BAR
#undef PG8_SCHED
}

struct EpiInProj {
    static constexpr bool PERM = true;
    bf16* P; const float* rope;
    DI void operator()(const f32x4 (&acc)[2][2][4][2], const Unit& u, int wr, int wc, int fr, int fq) const {
        const int row0 = u.pm * BM + wr * 64 + fr; const int colt = u.pn * BM; const int col0 = colt + wc * 32 + 8 * fq;
        const int kind = (u.pn < 5) ? 0 : ((u.pn < 19) ? 1 : 2);
        const float qs = (u.pn < 4) ? 0.125f : 1.0f;
        const int d0 = 16 * (wc & 1) + 4 * fq;
#pragma unroll
        for (int ai = 0; ai < 2; ++ai)
#pragma unroll
            for (int m = 0; m < 4; ++m) { const int row = row0 + ai * HALF + m * 16; bf16* rowp = P + (size_t)row * IN_COLS + col0;
                f32x4 cs = {1.f, 1.f, 1.f, 1.f}, sn = {0.f, 0.f, 0.f, 0.f};
                if (kind == 0) { const int pos = row & (SEQ - 1); cs = *(const GAS f32x4*)(rope + pos * 32 + d0); sn = *(const GAS f32x4*)(rope + SEQ * 32 + pos * 32 + d0); }
#pragma unroll
                for (int bj = 0; bj < 2; ++bj) { f32x4 v0 = acc[ai][bj][m][0], v1 = acc[ai][bj][m][1];
                    if (kind == 0) {
                        const f32x4 a0 = v0, a1 = v1;
                        v0[0] = (a0[0] * cs[0] - a0[1] * sn[0]) * qs; v0[1] = (a0[1] * cs[0] + a0[0] * sn[0]) * qs;
                        v0[2] = (a0[2] * cs[1] - a0[3] * sn[1]) * qs; v0[3] = (a0[3] * cs[1] + a0[2] * sn[1]) * qs;
                        v1[0] = (a1[0] * cs[2] - a1[1] * sn[2]) * qs; v1[1] = (a1[1] * cs[2] + a1[0] * sn[2]) * qs;
                        v1[2] = (a1[2] * cs[3] - a1[3] * sn[3]) * qs; v1[3] = (a1[3] * cs[3] + a1[2] * sn[3]) * qs;
                    } else if (kind == 2) {
                        f32x4 e0 = v0 * -1.44269504f, e1 = v1 * -1.44269504f;
#pragma unroll
                        for (int j = 0; j < 4; ++j) { e0[j] = __builtin_amdgcn_exp2f(e0[j]); e1[j] = __builtin_amdgcn_exp2f(e1[j]); }
                        e0 = e0 + 1.0f; e1 = e1 + 1.0f;
#pragma unroll
                        for (int j = 0; j < 4; ++j) { v0[j] = __builtin_amdgcn_rcpf(e0[j]); v1[j] = __builtin_amdgcn_rcpf(e1[j]); }
                    }
                    u32x4 w; w.x = cvt_pk_bf16(v0[0], v0[1]); w.y = cvt_pk_bf16(v0[2], v0[3]); w.z = cvt_pk_bf16(v1[0], v1[1]); w.w = cvt_pk_bf16(v1[2], v1[3]);
                    *(GAS u32x4*)(rowp + bj * HALF) = w; } }
    }
};
template <int MODE> struct EpiGate {
    static constexpr bool PERM = true;
    bf16* Mo; const bf16* Gp; unsigned char* M8;
    DI void operator()(const f32x4 (&acc)[2][2][4][2], const Unit& u, int wr, int wc, int fr, int fq) const {
        const int row0 = u.pm * BM + wr * 64 + fr; const int col0 = u.pn * BM + wc * 32 + 8 * fq;
#pragma unroll
        for (int ai = 0; ai < 2; ++ai)
#pragma unroll
            for (int m = 0; m < 4; ++m) { const int row = row0 + ai * HALF + m * 16;
#pragma unroll
                for (int bj = 0; bj < 2; ++bj) { const int col = col0 + bj * HALF;
                    const u32x4 g = *(const GAS u32x4*)(Gp + (size_t)row * IN_COLS + col);
                    f32x4 v0 = acc[ai][bj][m][0], v1 = acc[ai][bj][m][1];
                    v0[0] *= bflo(g.x); v0[1] *= bfhi(g.x); v0[2] *= bflo(g.y); v0[3] *= bfhi(g.y); v1[0] *= bflo(g.z); v1[1] *= bfhi(g.z); v1[2] *= bflo(g.w); v1[3] *= bfhi(g.w);
                    bf16* mp = Mo + (size_t)row * D + col;
                    if (MODE == 1) { const u32x4 o = *(const GAS u32x4*)mp;
                        v0[0] += bflo(o.x); v0[1] += bfhi(o.x); v0[2] += bflo(o.y); v0[3] += bfhi(o.y); v1[0] += bflo(o.z); v1[1] += bfhi(o.z); v1[2] += bflo(o.w); v1[3] += bfhi(o.w); }
                    if (MODE == 1) { v0 = v0 * 16.0f; v1 = v1 * 16.0f;
#pragma unroll
                        for (int j = 0; j < 4; ++j) { v0[j] = __builtin_amdgcn_fmed3f(v0[j], -448.0f, 448.0f); v1[j] = __builtin_amdgcn_fmed3f(v1[j], -448.0f, 448.0f); }
                        u32x2 w8; w8.x = pk4_fp8(v0[0], v0[1], v0[2], v0[3]); w8.y = pk4_fp8(v1[0], v1[1], v1[2], v1[3]);
                        *(GAS u32x2*)(M8 + (size_t)row * D + col) = w8; }
                    else { u32x4 w; w.x = cvt_pk_bf16(v0[0], v0[1]); w.y = cvt_pk_bf16(v0[2], v0[3]); w.z = cvt_pk_bf16(v1[0], v1[1]); w.w = cvt_pk_bf16(v1[2], v1[3]);
                    *(GAS u32x4*)mp = w; } } }
    }
};
struct EpiResid {
    static constexpr bool PERM = true;
    bf16* XBp; const float* X32;
    DI void operator()(const f32x4 (&acc)[2][2][4][2], const Unit& u, int wr, int wc, int fr, int fq) const {
        const int row0 = u.pm * BM + wr * 64 + fr; const int col0 = u.pn * BM + wc * 32 + 8 * fq;
#pragma unroll
        for (int ai = 0; ai < 2; ++ai)
#pragma unroll
            for (int m = 0; m < 4; ++m) { bf16* rowp = XBp + (size_t)(row0 + ai * HALF + m * 16) * D + col0;
#pragma unroll
                for (int bj = 0; bj < 2; ++bj) {
                    f32x4 v0 = acc[ai][bj][m][0], v1 = acc[ai][bj][m][1];
                    if (X32) { const float* xp = X32 + (size_t)(row0 + ai * HALF + m * 16) * D + col0 + bj * HALF; v0 += ALPHA * *(const GAS f32x4*)xp; v1 += ALPHA * *(const GAS f32x4*)(xp + 4); }
                    else { const u32x4 o = *(const GAS u32x4*)(rowp + bj * HALF);
                    v0[0] += ALPHA * bflo(o.x); v0[1] += ALPHA * bfhi(o.x); v0[2] += ALPHA * bflo(o.y); v0[3] += ALPHA * bfhi(o.y);
                    v1[0] += ALPHA * bflo(o.z); v1[1] += ALPHA * bfhi(o.z); v1[2] += ALPHA * bflo(o.w); v1[3] += ALPHA * bfhi(o.w); }
                    u32x4 w; w.x = cvt_pk_bf16(v0[0], v0[1]); w.y = cvt_pk_bf16(v0[2], v0[3]); w.z = cvt_pk_bf16(v1[0], v1[1]); w.w = cvt_pk_bf16(v1[2], v1[3]);
                    *(GAS u32x4*)(rowp + bj * HALF) = w; } }
    }
};
struct EpiSwiglu {
    static constexpr bool PERM = true;
    bf16* ACT; const float* b1;
    DI void operator()(const f32x4 (&acc)[2][2][4][2], const Unit& u, int wr, int wc, int fr, int fq) const {
        const int row0 = u.pm * BM + wr * 64 + fr; const int col0 = u.pn * BM + wc * 32 + 8 * fq;
        f32x4 bv[2][2];
#pragma unroll
        for (int bj = 0; bj < 2; ++bj)
#pragma unroll
            for (int n = 0; n < 2; ++n) bv[bj][n] = *(const GAS f32x4*)(b1 + (size_t)u.e * 2048 + col0 + bj * HALF + 4 * n);
#pragma unroll
        for (int ai = 0; ai < 2; ++ai)
#pragma unroll
            for (int m = 0; m < 4; ++m) { const int row = row0 + ai * HALF + m * 16;
#pragma unroll
                for (int bj = 0; bj < 2; ++bj) { const f32x4 v0 = acc[ai][bj][m][0] + bv[bj][0], v1 = acc[ai][bj][m][1] + bv[bj][1];
                    float o[4];
#pragma unroll
                    for (int j = 0; j < 4; ++j) { const float g = (j < 2) ? v0[2 * j] : v1[2 * j - 4], li = (j < 2) ? v0[2 * j + 1] : v1[2 * j - 3];
                        const float xg = fminf(g, 7.0f), xl = __builtin_amdgcn_fmed3f(li, -7.0f, 7.0f);
                        const f32x2 t = __builtin_elementwise_fma((f32x2){xg, xl}, (f32x2){-1.702f * 1.44269504f, 4.0f}, (f32x2){0.0f, 4.0f});
                        o[j] = (xg * __builtin_amdgcn_rcpf(1.0f + __builtin_amdgcn_exp2f(t[0]))) * t[1]; }
                    *(GAS unsigned*)((unsigned char*)ACT + (size_t)row * DE + ((col0 + bj * HALF) >> 1)) = pk4_fp8(o[0], o[1], o[2], o[3]); } }
    }
};
struct EpiYs {
    static constexpr bool PERM = true;
    unsigned char* YS; const float* b2;
    DI void operator()(const f32x4 (&acc)[2][2][4][2], const Unit& u, int wr, int wc, int fr, int fq) const {
        const int row0 = u.pm * BM + wr * 64 + fr; const int col0 = u.pn * BM + wc * 32 + 8 * fq;
        f32x4 bv[2][2];
#pragma unroll
        for (int bj = 0; bj < 2; ++bj)
#pragma unroll
            for (int n = 0; n < 2; ++n) bv[bj][n] = *(const GAS f32x4*)(b2 + (size_t)u.e * 1024 + col0 + bj * HALF + 4 * n) * 16.0f;
#pragma unroll
        for (int ai = 0; ai < 2; ++ai)
#pragma unroll
            for (int m = 0; m < 4; ++m) { unsigned char* rowp = YS + (size_t)(row0 + ai * HALF + m * 16) * D + col0;
#pragma unroll
                for (int bj = 0; bj < 2; ++bj) { f32x4 v0 = acc[ai][bj][m][0] * 16.0f + bv[bj][0], v1 = acc[ai][bj][m][1] * 16.0f + bv[bj][1];
#pragma unroll
                    for (int j = 0; j < 4; ++j) { v0[j] = __builtin_amdgcn_fmed3f(v0[j], -448.0f, 448.0f); v1[j] = __builtin_amdgcn_fmed3f(v1[j], -448.0f, 448.0f); }
                    u32x2 w; w.x = pk4_fp8(v0[0], v0[1], v0[2], v0[3]); w.y = pk4_fp8(v1[0], v1[1], v1[2], v1[3]);
                    *(GAS u32x2*)(rowp + bj * HALF) = w; } }
    }
};
}

struct Args { const float* in[30]; float* out; unsigned char* ws; int ph_lo, ph_hi, one_launch, pad; };
struct Frame {
    LAS unsigned char* lds;
    int tid, lane, wave, G, bid;
    unsigned char* ws; float* out;
};
#define IN_X 0
#define IN_WIN 1
#define IN_SINKS 2
#define IN_WAO 3
#define IN_MU 4
#define IN_W0 5
#define IN_W2 6
#define IN_A0 7
#define IN_A2 8
#define IN_G2 9
#define IN_KK 10
#define IN_KA 11
#define IN_RK 12
#define IN_V0 13
#define IN_V1 14
#define IN_V2 15
#define IN_LNXW 16
#define IN_LNXB 17
#define IN_WRO 18
#define IN_WOUT 19
#define IN_LN1G 20
#define IN_LN1B 21
#define IN_ROUTW 22
#define IN_ROUTB 23
#define IN_EW1 24
#define IN_EB1 25
#define IN_EW2 26
#define IN_EB2 27
#define IN_LN2G 28
#define IN_LN2B 29


DI const float* inptr(int i) {
    const __attribute__((address_space(4))) char* kp = (const __attribute__((address_space(4))) char*)__builtin_amdgcn_kernarg_segment_ptr();
    asm volatile("" : "+s"(kp));
    const float* p = *(const float* const __attribute__((address_space(4)))*)(kp + 8 * i);
    return (const float*)(const GAS float*)p;
}

template <bool QKPERM>
DI void transpose_item(const float* W, int K, int N, bf16* WT, LAS float* scr, int item, int lane) {
    const int nblk = N / 32, kb = item / nblk, nb = item % nblk, k0 = 64 * kb, n0 = 32 * nb;
    int nsrc = n0 + (lane & 31);
    if (QKPERM && nsrc < 1280) { const int j = nsrc & 63; nsrc = (nsrc & ~63) + (j >> 1) + 32 * (j & 1); }
#pragma unroll 8
    for (int i = 0; i < 32; ++i) { const int kk = 2 * i + (lane >> 5); scr[kk * 33 + (lane & 31)] = W[(size_t)(k0 + kk) * N + nsrc]; }
    asm volatile("s_waitcnt lgkmcnt(0)" ::: "memory");
    const int c = lane & 7;
#pragma unroll
    for (int j = 0; j < 4; ++j) { const int n = (lane >> 3) + 8 * j; const LAS float* s = scr + (8 * c) * 33 + n;
        u32x4 o; o.x = pk2(s[0 * 33], s[1 * 33]); o.y = pk2(s[2 * 33], s[3 * 33]); o.z = pk2(s[4 * 33], s[5 * 33]); o.w = pk2(s[6 * 33], s[7 * 33]);
        *(GAS u32x4*)(WT + (size_t)(n0 + n) * K + k0 + 8 * c) = o; }
    asm volatile("s_waitcnt lgkmcnt(0)" ::: "memory");
}
template <bool QKPERM = false>
DI void transpose_item_fp8(const float* W, int K, int N, unsigned char* WT, LAS float* scr, int item, int lane, float scale) {
    const int nblk = N / 32, kb = item / nblk, nb = item % nblk, k0 = 64 * kb, n0 = 32 * nb;
    int nsrc = n0 + (lane & 31);
    if (QKPERM && nsrc < 1280) { const int j = nsrc & 63; nsrc = (nsrc & ~63) + (j >> 1) + 32 * (j & 1); }
#pragma unroll 8
    for (int i = 0; i < 32; ++i) { const int kk = 2 * i + (lane >> 5); scr[kk * 33 + (lane & 31)] = W[(size_t)(k0 + kk) * N + nsrc] * scale; }
    asm volatile("s_waitcnt lgkmcnt(0)" ::: "memory");
#pragma unroll
    for (int j = 0; j < 2; ++j) { const int id = lane + 64 * j, n = id >> 2, c = id & 3; const LAS float* q = scr + (16 * c) * 33 + n;
        u32x4 o; o.x = pk4_fp8(q[0 * 33], q[1 * 33], q[2 * 33], q[3 * 33]); o.y = pk4_fp8(q[4 * 33], q[5 * 33], q[6 * 33], q[7 * 33]);
        o.z = pk4_fp8(q[8 * 33], q[9 * 33], q[10 * 33], q[11 * 33]); o.w = pk4_fp8(q[12 * 33], q[13 * 33], q[14 * 33], q[15 * 33]);
        *(GAS u32x4*)(WT + (size_t)(n0 + n) * K + k0 + 16 * c) = o; }
    asm volatile("s_waitcnt lgkmcnt(0)" ::: "memory");
}
constexpr int CV_ITEMS = 32 * 64 * 32 + 32 * 64 * 16;
DI bool cv_in_scan(int G) { return G * 4 * 128 >= CV_ITEMS && G <= BATCH * 16; }
DI void phase_weights(Frame& F, const Args& a, int l) {
    LAS float* scr = (LAS float*)(F.lds + F.wave * 16384);
    const int gw = F.bid * 8 + F.wave, NGW = F.G * 8;
    unsigned char* ws = F.ws;
    constexpr int I_IN = 16 * (IN_COLS / 32), I_SQ = 16 * 32, I_W1 = 16 * 64, I_W2 = 16 * 32;
    const int NITEMS = I_IN + 3 * I_SQ + (cv_in_scan(F.G) ? 0 : 32 * I_W1 + 32 * I_W2);
    for (int it = gw; it < NITEMS; it += NGW) {
        int r = it;
        if (r < I_IN) { transpose_item_fp8<true>(inptr(IN_WIN) + (size_t)l * D * IN_COLS, D, IN_COLS, (unsigned char*)(ws + WS_WIN), scr, r, F.lane, 32.0f); continue; } r -= I_IN;
        if (r < I_SQ) { transpose_item_fp8<false>(inptr(IN_WAO) + (size_t)l * D * D, D, D, (unsigned char*)(ws + WS_WAO), scr, r, F.lane, 32.0f); continue; } r -= I_SQ;
        if (r < I_SQ) { transpose_item_fp8<false>(inptr(IN_WRO) + (size_t)l * D * D, D, D, (unsigned char*)(ws + WS_WRO), scr, r, F.lane, 32.0f); continue; } r -= I_SQ;
        if (r < I_SQ) { transpose_item_fp8<false>(inptr(IN_WOUT) + (size_t)l * D * D, D, D, (unsigned char*)(ws + WS_WOUT), scr, r, F.lane, 32.0f); continue; } r -= I_SQ;
        if (r < 32 * I_W1) { const int e = r / I_W1; transpose_item_fp8(inptr(IN_EW1) + ((size_t)l * NE + e) * D * 2048, D, 2048, (unsigned char*)(ws + WS_W1) + (size_t)e * 2048 * 1024, scr, r % I_W1, F.lane, 32.0f); continue; } r -= 32 * I_W1;
        { const int e = r / I_W2; transpose_item_fp8(inptr(IN_EW2) + ((size_t)l * NE + e) * DE * D, DE, D, (unsigned char*)(ws + WS_W2) + (size_t)e * 1024 * 1024, scr, r % I_W2, F.lane, 64.0f); }
    }
    {
        const float* rw = inptr(IN_ROUTW) + (size_t)l * D * NE; const float* g1 = inptr(IN_LN1G) + l * D; const float* b1 = inptr(IN_LN1B) + l * D;
        unsigned short* img = (unsigned short*)(ws + WS_RIMG);
        for (int idx = F.bid * 512 + F.tid; idx < D * NE; idx += F.G * 512) { const int d = idx >> 5, e = idx & 31; const float x = rw[idx] * g1[d]; const unsigned hi = f2bf(x); const unsigned lo = f2bf(x - bf2f((unsigned short)hi));
            img[e * D + d] = (unsigned short)hi; img[NE * D + e * D + d] = (unsigned short)lo; }
        if (gw < NE) { float cs = 0.f, ce = 0.f;
            for (int d = F.lane; d < D; d += 64) { const float wv = rw[d * NE + gw]; cs += wv * g1[d]; ce += wv * b1[d]; }
            cs = wave_sum(cs); ce = wave_sum(ce);
            if (F.lane == 0) { float* cse = (float*)(ws + WS_RIMG + 2 * NE * D * 2); cse[gw] = cs; cse[NE + gw] = ce + inptr(IN_ROUTB)[l * NE + gw]; } }
    }
    const int gt = F.bid * 512 + F.tid, NGT = F.G * 512;
    bf16* lo = (bf16*)(ws + WS_LORA);
    for (int i = gt; i < 1024 * 64; i += NGT) { const int c = i >> 6, m = i & 63;
        lo[LO_W2 / 2 + i] = (bf16)f2bf(inptr(IN_W2)[(size_t)l * 64 * 1024 + m * 1024 + c]);
        lo[LO_A2 / 2 + i] = (bf16)f2bf(inptr(IN_A2)[(size_t)l * 64 * 1024 + m * 1024 + c]); }
    for (int i = gt; i < 1024 * 128; i += NGT) { const int c = i >> 7, m = i & 127; lo[LO_G2 / 2 + i] = (bf16)f2bf(inptr(IN_G2)[(size_t)l * 128 * 1024 + m * 1024 + c]); }
    if (l > 0) {
        for (int i = gt; i < 1024 * 32; i += NGT) { const int c = i >> 5, m = i & 31; lo[LO_V2 / 2 + i] = (bf16)f2bf(inptr(IN_V2)[(size_t)(l - 1) * 32 * 1024 + m * 1024 + c]); }
        for (int i = gt; i < 32 * 1024; i += NGT) { const int m = i >> 10, d = i & 1023; lo[LO_V1 / 2 + i] = (bf16)f2bf(inptr(IN_V1)[(size_t)(l - 1) * 1024 * 32 + d * 32 + m]); }
    }
    if (l == 0) {
        const f32x4* xs = (const f32x4*)inptr(IN_X);
        unsigned* xi8 = (unsigned*)(ws + WS_XI8);
        for (size_t i = gt; i < (size_t)T * D / 4; i += NGT) { const f32x4 v = xs[i]; xi8[i] = pk4_fp8(v[0], v[1], v[2], v[3]); }
        float* rope = (float*)(ws + WS_ROPE);
        for (int i = gt; i < SEQ * 32; i += NGT) { const int pos = i >> 5, d = i & 31; const float inv = powf(10000.0f, -(float)(2 * d) / 64.0f); const float ang = (float)pos * inv;
            float sn, cs; sincosf(ang, &sn, &cs); rope[i] = cs; rope[SEQ * 32 + i] = sn; }
    }
}

DI int crow(int reg, int h) { return (reg & 3) + 8 * (reg >> 2) + 4 * h; }
#define MFMA32(a, b, c) __builtin_amdgcn_mfma_f32_32x32x16_bf16((a), (b), (c), 0, 0, 0)
DI void phase_attn(Frame& F, const Args& a, int l) {
    constexpr int KP = 144, VP = 192;
    LAS unsigned char* KL = F.lds; LAS unsigned char* VL = F.lds + 256 * KP;
    bf16* P = (bf16*)(F.ws + WS_R);
    const float* sinks = inptr(IN_SINKS) + l * NQH;
    const int lane = F.lane, r = lane & 31, h = lane >> 5, w = F.wave;
    const int i16 = lane & 15, tq = i16 >> 2, tp = i16 & 3, blk = (lane >> 4) & 1;
    auto kv_load = [&](int u, u32x4 (&kr)[4], u32x4 (&vr)[4]) { const int hk = u & 3, n = (u >> 2) & 31, b = u >> 7; const int row0 = b * SEQ + n * 128;
#pragma unroll
        for (int q = 0; q < 4; ++q) { const int idx = F.tid + 512 * q, j = idx >> 3, c8 = idx & 7; const int src = (n == 0 && j < 128) ? row0 + j : row0 - 128 + j;
            kr[q] = *(const GAS u32x4*)(P + (size_t)src * IN_COLS + C_K + 64 * hk + 8 * c8); vr[q] = *(const GAS u32x4*)(P + (size_t)src * IN_COLS + C_V + 64 * hk + 8 * c8); } };
    u32x4 kr[4], vr[4];
    if (F.bid < BATCH * 32 * NKVH) kv_load(F.bid, kr, vr);
    for (int u = F.bid; u < BATCH * 32 * NKVH; u += F.G) {
        const int hk = u & 3, n = (u >> 2) & 31, b = u >> 7;
        const int row0 = b * SEQ + n * 128;
        const int g = 4 * hk + (w >> 1);
        bf16x8 Bq2[2][4];
#pragma unroll
        for (int sb = 0; sb < 2; ++sb)
#pragma unroll
            for (int ks = 0; ks < 4; ++ks) Bq2[sb][ks] = *(const GAS bf16x8*)(P + (size_t)(row0 + 64 * (w & 1) + 32 * sb + r) * IN_COLS + C_Q + 64 * g + 16 * ks + 8 * h);
        __syncthreads();
#pragma unroll
        for (int q = 0; q < 4; ++q) { const int idx = F.tid + 512 * q, j = idx >> 3, c8 = idx & 7; *(LAS u32x4*)(KL + j * KP + 16 * c8) = kr[q]; *(LAS u32x4*)(VL + j * VP + 16 * c8) = vr[q]; }
        __syncthreads();
        if (u + F.G < BATCH * 32 * NKVH) kv_load(u + F.G, kr, vr);
        const float sink = sinks[g];
#pragma unroll 1
        for (int sb = 0; sb < 2; ++sb) {
            const int q0 = 64 * (w & 1) + 32 * sb;
            unsigned char* arow = F.ws + WS_ATT8 + (size_t)(row0 + q0 + r) * D + 64 * g;
            bf16x8 Bq[4];
#pragma unroll
            for (int ks = 0; ks < 4; ++ks) Bq[ks] = sb ? Bq2[1][ks] : Bq2[0][ks];
            f32x16 sc[5];
#pragma unroll
            for (int tt = 0; tt < 5; ++tt) { const int jb = q0 + 32 * tt;
#pragma unroll
                for (int i = 0; i < 16; ++i) sc[tt][i] = 0.f;
#pragma unroll
                for (int ks = 0; ks < 4; ++ks) { const bf16x8 ak = *(const LAS bf16x8*)(KL + (jb + r) * KP + (16 * ks + 8 * h) * 2); sc[tt] = MFMA32(ak, Bq[ks], sc[tt]); } }
            float mx = sink;
            if (n == 0) {
#pragma unroll
                for (int tt = 0; tt < 5; ++tt)
#pragma unroll
                    for (int i = 0; i < 16; ++i) sc[tt][i] = (q0 + 32 * tt + crow(i, h) >= 128) ? sc[tt][i] : -INFINITY;
            }
#pragma unroll
            for (int tt = 0; tt < 5; ++tt)
#pragma unroll
                for (int i = 0; i < 16; ++i) { const int c = crow(i, h);
                    if (tt == 0) sc[tt][i] = (c > r) ? sc[tt][i] : -INFINITY;
                    if (tt == 4) sc[tt][i] = (c <= r) ? sc[tt][i] : -INFINITY;
                    mx = fmaxf(mx, sc[tt][i]); }
            mx = fmaxf(mx, shx(mx, 32, lane));
            const float mxl = mx * 1.44269504f;
            f32x2 sum2 = {0.f, 0.f};
#pragma unroll
            for (int tt = 0; tt < 5; ++tt)
#pragma unroll
                for (int i = 0; i < 8; ++i) { f32x2 e = (f32x2){sc[tt][2 * i], sc[tt][2 * i + 1]} * 1.44269504f - mxl;
                    e[0] = __builtin_amdgcn_exp2f(e[0]); e[1] = __builtin_amdgcn_exp2f(e[1]); sc[tt][2 * i] = e[0]; sc[tt][2 * i + 1] = e[1]; sum2 = sum2 + e; }
            float sum = sum2[0] + sum2[1];
            sum += shx(sum, 32, lane);
            const float inv = 1.0f / (sum + __expf(sink - mx));
            f32x16 ot[2];
#pragma unroll
            for (int i = 0; i < 16; ++i) { ot[0][i] = 0.f; ot[1][i] = 0.f; }
#pragma unroll
            for (int tt = 0; tt < 5; ++tt)
#pragma unroll
                for (int s = 0; s < 2; ++s) {
                    u32x4 pw; pw.x = pk2(sc[tt][8 * s + 0], sc[tt][8 * s + 1]); pw.y = pk2(sc[tt][8 * s + 2], sc[tt][8 * s + 3]); pw.z = pk2(sc[tt][8 * s + 4], sc[tt][8 * s + 5]); pw.w = pk2(sc[tt][8 * s + 6], sc[tt][8 * s + 7]);
                    const bf16x8 Bp = __builtin_bit_cast(bf16x8, pw);
                    const int key0 = q0 + 32 * tt + 16 * s + 4 * h + tq;
#pragma unroll
                    for (int db = 0; db < 2; ++db) {
                        const LAS unsigned char* vp = VL + key0 * VP + (32 * db + 16 * blk) * 2 + 8 * tp;
                        const s16x4 lo = __builtin_bit_cast(s16x4, __builtin_amdgcn_ds_read_tr16_b64_v4i16((LAS s16x4*)vp));
                        const s16x4 hi = __builtin_bit_cast(s16x4, __builtin_amdgcn_ds_read_tr16_b64_v4i16((LAS s16x4*)(vp + 8 * VP)));
                        const bf16x8 Av = __builtin_shufflevector(lo, hi, 0, 1, 2, 3, 4, 5, 6, 7);
                        ot[db] = MFMA32(Av, Bp, ot[db]); } }
#pragma unroll
            for (int db = 0; db < 2; ++db)
#pragma unroll
                for (int gq = 0; gq < 4; ++gq) { const float i16 = inv * 16.0f;
                    *(GAS unsigned*)(arow + 32 * db + 8 * gq + 4 * h) = pk4_fp8(ot[db][4 * gq] * i16, ot[db][4 * gq + 1] * i16, ot[db][4 * gq + 2] * i16, ot[db][4 * gq + 3] * i16); }
        }
    }
    {
        const float* mu = inptr(IN_MU) + (size_t)l * RWKV_COLS + (C_WL - C_R);
        bf16* LI = (bf16*)(F.ws + WS_LI);
        for (size_t it = (size_t)F.bid * 512 + F.tid; it < (size_t)T * 32; it += (size_t)F.G * 512) { const int tok = (int)(it >> 5), cg = (int)(it & 31);
            const bf16* pc = P + (size_t)tok * IN_COLS + C_WL + 8 * cg;
            const u32x4 c4 = *(const GAS u32x4*)pc; u32x4 p4 = {0u, 0u, 0u, 0u}; if ((tok & (SEQ - 1)) != 0) p4 = *(const GAS u32x4*)(pc - IN_COLS);
            const f32x4 m0 = *(const GAS f32x4*)(mu + 8 * cg), m1 = *(const GAS f32x4*)(mu + 8 * cg + 4);
            float xs[8], ps[8];
            xs[0] = bflo(c4.x); xs[1] = bfhi(c4.x); xs[2] = bflo(c4.y); xs[3] = bfhi(c4.y); xs[4] = bflo(c4.z); xs[5] = bfhi(c4.z); xs[6] = bflo(c4.w); xs[7] = bfhi(c4.w);
            ps[0] = bflo(p4.x); ps[1] = bfhi(p4.x); ps[2] = bflo(p4.y); ps[3] = bfhi(p4.y); ps[4] = bflo(p4.z); ps[5] = bfhi(p4.z); ps[6] = bflo(p4.w); ps[7] = bfhi(p4.w);
#pragma unroll
            for (int j = 0; j < 8; ++j) { float x = xs[j] + (ps[j] - xs[j]) * (j < 4 ? m0[j] : m1[j - 4]); if (cg < 8) x = tanh_fast(x); else if (cg >= 16) x = sigmoidf_(x); xs[j] = x; }
            u32x4 o; o.x = pk2(xs[0], xs[1]); o.y = pk2(xs[2], xs[3]); o.z = pk2(xs[4], xs[5]); o.w = pk2(xs[6], xs[7]);
            *(GAS u32x4*)(LI + (size_t)tok * 256 + 8 * cg) = o; }
    }
    if (l > 0) {
        constexpr int RPB = 2064;
        LAS unsigned char* V1I = F.lds; LAS float* MUL = (LAS float*)(F.lds + 32 * RPB); LAS unsigned char* STG = F.lds + 32 * RPB + 4096 + w * 2112;
        const unsigned char* v1t = F.ws + WS_LORA + LO_V1;
        const float* mu = inptr(IN_MU) + (size_t)l * RWKV_COLS + (C_RV - C_R);
        bf16* VLo = (bf16*)(F.ws + WS_VL);
        __syncthreads();
        for (int i = F.tid; i < 32 * 128; i += 512) { const int row = i >> 7, c16 = i & 127; *(LAS u32x4*)(V1I + row * RPB + c16 * 16) = *(const GAS u32x4*)(v1t + (size_t)row * 2048 + c16 * 16); }
        if (F.tid < 256) *(LAS f32x4*)(MUL + 4 * F.tid) = *(const GAS f32x4*)(mu + 4 * F.tid);
        __syncthreads();
        for (int rbk = F.bid * 8 + w; rbk < T / 32; rbk += F.G * 8) {
            const int t0 = rbk * 32, s0 = lane >> 2; const bool zf = ((t0 & (SEQ - 1)) == 0) && (s0 == 0);
            const bf16* pa = P + (size_t)(t0 - 1 + s0 + (zf ? 1 : 0)) * IN_COLS + C_RV + 8 * (lane & 3);
            const bf16* pb = P + (size_t)(t0 + 15 + s0) * IN_COLS + C_RV + 8 * (lane & 3);
            const bf16* pc = P + (size_t)(t0 + 31) * IN_COLS + C_RV + 8 * (lane & 3);
            const u32x4 z4 = {0u, 0u, 0u, 0u};
            u32x4 c0 = *(const GAS u32x4*)pa, c1 = *(const GAS u32x4*)pb, c2 = z4; if (lane < 4) c2 = *(const GAS u32x4*)pc;
            f32x16 acc;
#pragma unroll
            for (int i = 0; i < 16; ++i) acc[i] = 0.f;
#pragma unroll 2
            for (int ch = 0; ch < 32; ++ch) {
                u32x4 n0 = c0, n1 = c1, n2 = c2;
                if (ch + 1 < 32) { n0 = *(const GAS u32x4*)(pa + 32 * (ch + 1)); n1 = *(const GAS u32x4*)(pb + 32 * (ch + 1)); if (lane < 4) n2 = *(const GAS u32x4*)(pc + 32 * (ch + 1)); }
                *(LAS u32x4*)(STG + lane * 16) = zf ? z4 : c0; *(LAS u32x4*)(STG + 1024 + lane * 16) = c1; if (lane < 4) *(LAS u32x4*)(STG + 2048 + lane * 16) = c2;
#pragma unroll
                for (int ks = 0; ks < 2; ++ks) { const int d = 32 * ch + 16 * ks + 8 * h;
                    const u32x4 c4 = *(const LAS u32x4*)(STG + (r + 1) * 64 + (2 * ks + h) * 16), p4 = *(const LAS u32x4*)(STG + r * 64 + (2 * ks + h) * 16);
                    const f32x4 m0 = *(const LAS f32x4*)(MUL + d), m1 = *(const LAS f32x4*)(MUL + d + 4);
                    float xs[8], ps[8];
                    xs[0] = bflo(c4.x); xs[1] = bfhi(c4.x); xs[2] = bflo(c4.y); xs[3] = bfhi(c4.y); xs[4] = bflo(c4.z); xs[5] = bfhi(c4.z); xs[6] = bflo(c4.w); xs[7] = bfhi(c4.w);
                    ps[0] = bflo(p4.x); ps[1] = bfhi(p4.x); ps[2] = bflo(p4.y); ps[3] = bfhi(p4.y); ps[4] = bflo(p4.z); ps[5] = bfhi(p4.z); ps[6] = bflo(p4.w); ps[7] = bfhi(p4.w);
#pragma unroll
                    for (int j = 0; j < 8; ++j) xs[j] = xs[j] + (ps[j] - xs[j]) * (j < 4 ? m0[j] : m1[j - 4]);
                    u32x4 aw; aw.x = pk2(xs[0], xs[1]); aw.y = pk2(xs[2], xs[3]); aw.z = pk2(xs[4], xs[5]); aw.w = pk2(xs[6], xs[7]);
                    const bf16x8 bv = *(const LAS bf16x8*)(V1I + r * RPB + d * 2);
                    acc = MFMA32(__builtin_bit_cast(bf16x8, aw), bv, acc); }
                asm volatile("s_waitcnt lgkmcnt(0)" ::: "memory");
                c0 = n0; c1 = n1; c2 = n2;
            }
#pragma unroll
            for (int i = 0; i < 16; ++i) VLo[(size_t)(t0 + crow(i, h)) * 32 + r] = (bf16)(pk2(acc[i], acc[i]) & 0xffffu);
        }
    }
}

DI bf16x8 frag_row(const LAS unsigned char* base, int pitch, int row, int kelem) { return *(const LAS bf16x8*)(base + row * pitch + kelem * 2); }
DI bf16x8 frag_row_perm(const LAS unsigned char* base, int pitch, int row, int k0, int h) {
    const s16x4 lo = *(const LAS s16x4*)(base + row * pitch + (k0 + 4 * h) * 2), hi = *(const LAS s16x4*)(base + row * pitch + (k0 + 8 + 4 * h) * 2);
    return __builtin_shufflevector(lo, hi, 0, 1, 2, 3, 4, 5, 6, 7); }
DI s16x4 tr4(const LAS unsigned char* p) { return __builtin_bit_cast(s16x4, __builtin_amdgcn_ds_read_tr16_b64_v4i16((LAS s16x4*)p)); }
DI bf16x8 frag_tr(const LAS unsigned char* base, int pitch, int k0, int col0, int lane) {
    const int h = lane >> 5, i16 = lane & 15, tq = i16 >> 2, tp = i16 & 3, blk = (lane >> 4) & 1;
    const LAS unsigned char* p = base + (k0 + 4 * h + tq) * pitch + (col0 + 16 * blk) * 2 + 8 * tp;
    const s16x4 lo = tr4(p), hi = tr4(p + 8 * pitch);
    return __builtin_shufflevector(lo, hi, 0, 1, 2, 3, 4, 5, 6, 7); }
DI f32x16 zero16() { f32x16 z;
#pragma unroll
    for (int i = 0; i < 16; ++i) z[i] = 0.f;
    return z; }
DI f32x16 acc_from_tr(const LAS unsigned char* base, int pitch, int row0, int col0, int lane) {
    const int h = lane >> 5, i16 = lane & 15, tq = i16 >> 2, tp = i16 & 3, blk = (lane >> 4) & 1;
    f32x16 o;
#pragma unroll
    for (int g = 0; g < 4; ++g) { const s16x4 q = tr4(base + (row0 + 8 * g + 4 * h + tq) * pitch + (col0 + 16 * blk) * 2 + 8 * tp);
#pragma unroll
        for (int e = 0; e < 4; ++e) o[4 * g + e] = bf2f((unsigned short)q[e]); }
    return o; }
DI void identity_frags(int r, int h, bf16x8 (&idf)[2]) {
#pragma unroll
    for (int ks = 0; ks < 2; ++ks) { const int e = r - 16 * ks - 8 * h;
#pragma unroll
        for (int j = 0; j < 8; ++j) idf[ks][j] = (e == j) ? (short)0x3F80 : (short)0; } }
DI f32x16 acc_by_mfma(const LAS unsigned char* base, int pitch, int row0, int col0, int r, int h, const bf16x8 (&idf)[2]) {
    f32x16 d = MFMA32(frag_row(base, pitch, row0 + r, col0 + 8 * h), idf[0], zero16());
    return MFMA32(frag_row(base, pitch, row0 + r, col0 + 16 + 8 * h), idf[1], d); }
DI bf16x8 packacc(const f32x16& x, int s) {
    u32x4 p; p.x = pk2(x[8 * s + 0], x[8 * s + 1]); p.y = pk2(x[8 * s + 2], x[8 * s + 3]); p.z = pk2(x[8 * s + 4], x[8 * s + 5]); p.w = pk2(x[8 * s + 6], x[8 * s + 7]);
    return __builtin_bit_cast(bf16x8, p); }

DI f32x16 gram(const LAS unsigned char* X, const LAS unsigned char* Y, int pitch, int r, int h) {
    f32x16 acc = zero16();
#pragma unroll
    for (int ks = 0; ks < 4; ++ks) acc = MFMA32(frag_row(X, pitch, r, 16 * ks + 8 * h), frag_row(Y, pitch, r, 16 * ks + 8 * h), acc);
    return acc; }
DI f32x16 mm_tt(const f32x16& X, const f32x16& Y, f32x16 acc) { const bf16x8 x0 = packacc(X, 0), x1 = packacc(X, 1), y0 = packacc(Y, 0), y1 = packacc(Y, 1); acc = MFMA32(x0, y0, acc); acc = MFMA32(x1, y1, acc); return acc; }

DI int lane_now() { unsigned z_ = 0u; asm volatile("" : "+v"(z_)); return (int)__builtin_amdgcn_mbcnt_hi(~0u, __builtin_amdgcn_mbcnt_lo(~0u, z_)); }
DI void bar_lds() { asm volatile("s_waitcnt lgkmcnt(0)" ::: "memory"); __builtin_amdgcn_s_barrier(); asm volatile("" ::: "memory"); }
DI float half_sum(float v, int h) {
    DPP_ADD_(v, 0xB1, 0xf); DPP_ADD_(v, 0x4E, 0xf); DPP_ADD_(v, 0x141, 0xf); DPP_ADD_(v, 0x140, 0xf);
    (void)h;
    return v + __builtin_bit_cast(float, __builtin_amdgcn_ds_swizzle(__builtin_bit_cast(int, v), 0x401F)); }
DI bf16x8 lora_afrag(const bf16* P, int tok, int col, const float* mu_rw, int act) {
    const u32x4 c4 = *(const GAS u32x4*)(P + (size_t)tok * IN_COLS + col); u32x4 p4 = {0u, 0u, 0u, 0u};
    if ((tok & (SEQ - 1)) != 0) p4 = *(const GAS u32x4*)(P + (size_t)(tok - 1) * IN_COLS + col);
    const f32x4 m0 = *(const GAS f32x4*)(mu_rw + col - C_R), m1 = *(const GAS f32x4*)(mu_rw + col - C_R + 4);
    float xs[8], ps[8];
    xs[0] = bflo(c4.x); xs[1] = bfhi(c4.x); xs[2] = bflo(c4.y); xs[3] = bfhi(c4.y); xs[4] = bflo(c4.z); xs[5] = bfhi(c4.z); xs[6] = bflo(c4.w); xs[7] = bfhi(c4.w);
    ps[0] = bflo(p4.x); ps[1] = bfhi(p4.x); ps[2] = bflo(p4.y); ps[3] = bfhi(p4.y); ps[4] = bflo(p4.z); ps[5] = bfhi(p4.z); ps[6] = bflo(p4.w); ps[7] = bfhi(p4.w);
#pragma unroll
    for (int j = 0; j < 8; ++j) { float x = xs[j] + (ps[j] - xs[j]) * (j < 4 ? m0[j] : m1[j - 4]); if (act == 1) x = tanh_fast(x); else if (act == 2) x = sigmoidf_(x); xs[j] = x; }
    u32x4 o; o.x = pk2(xs[0], xs[1]); o.y = pk2(xs[2], xs[3]); o.z = pk2(xs[4], xs[5]); o.w = pk2(xs[6], xs[7]);
    return __builtin_bit_cast(bf16x8, o); }
DI void load_shift16(const bf16* P, int t0, int colc, float muc, int h, float (&o)[16]) {
    unsigned short cu[16], pv[16];
#pragma unroll
    for (int i = 0; i < 16; ++i) { const int tok = t0 + crow(i, h); cu[i] = *(const GAS unsigned short*)(P + (size_t)tok * IN_COLS + colc); pv[i] = 0; if ((tok & (SEQ - 1)) != 0) pv[i] = *(const GAS unsigned short*)(P + (size_t)(tok - 1) * IN_COLS + colc); }
#pragma unroll
    for (int i = 0; i < 16; ++i) { const float c = bf2f(cu[i]), p = bf2f(pv[i]); o[i] = c + (p - c) * muc; } }

DI void phase_scan(Frame& F, const Args& a, int l) {
    constexpr int CH = 32, PB = 144, PQ = 136, NCHK = SEQ / CH, NP = NCHK + 6;
    constexpr int GSLOT = 4 * 32 * PB + 256;
    constexpr int PSLOT = 2 * 32 * PQ + 128;
    constexpr int QBUF = 96 * PQ;
    constexpr int OBUF = 32 * PQ;
    constexpr int SBUF = 9 * 1024;
    LAS unsigned char* GS = F.lds; LAS unsigned char* PS = GS + 2 * GSLOT; LAS unsigned char* QB = PS + 4 * PSLOT; LAS unsigned char* OB = QB + 2 * QBUF;
    LAS unsigned char* SBb = OB + 2 * OBUF;
    LAS float* CT = (LAS float*)(SBb + 4 * SBUF);
    constexpr int CVB = 4096;
    LAS unsigned char* CVb = (LAS unsigned char*)CT + 2304;
    static_assert(2 * GSLOT + 4 * PSLOT + 2 * QBUF + 2 * OBUF + 4 * SBUF + 2304 + 4 * CVB <= L_BARST, "scan LDS");
    const bf16* P = (const bf16*)(F.ws + WS_R);
    bf16* VF = (bf16*)(F.ws + WS_VF); unsigned char* RWO8 = F.ws + WS_RWO;
    const bf16* VLi = (const bf16*)(F.ws + WS_VL);
    const bf16* lora = (const bf16*)(F.ws + WS_LORA);
    const float* mu = inptr(IN_MU) + (size_t)l * RWKV_COLS;
    const int w = F.wave;
    for (int bh = F.bid; bh < BATCH * 16; bh += F.G) {
        const int b = bh >> 4, hd = bh & 15;
        __syncthreads();
        if (w == 0) { int ln0_ = lane_now(); const int cc = l * 1024 + 64 * hd + ln0_, cm = 64 * hd + ln0_;
            CT[ln0_] = inptr(IN_W0)[cc]; CT[64 + ln0_] = inptr(IN_A0)[cc]; CT[128 + ln0_] = (l > 0) ? inptr(IN_V0)[(l - 1) * 1024 + cm] : 0.f; CT[192 + ln0_] = inptr(IN_KK)[cc]; CT[256 + ln0_] = inptr(IN_KA)[cc];
            CT[320 + ln0_] = inptr(IN_RK)[cc]; CT[384 + ln0_] = mu[cm]; CT[448 + ln0_] = mu[1024 + cm]; CT[512 + ln0_] = mu[2048 + cm]; }
        __syncthreads();
        auto post_tokens = [&](int cp, int tlo, int lane, float lnw, float lnb) {
            const LAS unsigned char* ps = PS + (cp & 3) * PSLOT; const LAS unsigned char* cV = ps; const LAS unsigned char* cG = ps + 32 * PQ; const LAS float* RK = (const LAS float*)(ps + 64 * PQ);
            const LAS unsigned char* ob = OB + (cp & 1) * OBUF;
            const int tg = b * SEQ + cp * CH;
            f32x16 D1 = zero16(), D2 = zero16();
            { const int r = lane & 31, h = lane >> 5; const bf16x8 ones = {0x3F80, 0x3F80, 0x3F80, 0x3F80, 0x3F80, 0x3F80, 0x3F80, 0x3F80};
#pragma unroll
              for (int ks = 0; ks < 4; ++ks) { const LAS unsigned char* fp = ob + (tlo + (r & 7)) * PQ + (16 * ks + 8 * h) * 2;
                  const s16x4 flo = *(const LAS s16x4*)fp, fhi = *(const LAS s16x4*)(fp + 8); const bf16x8 f = __builtin_shufflevector(flo, fhi, 0, 1, 2, 3, 4, 5, 6, 7); D1 = MFMA32(f, ones, D1); D2 = MFMA32(f, f, D2); } }
            float R[4], NB[4];
#pragma unroll
            for (int i = 0; i < 4; ++i) { const float m = D1[i] * (1.0f / 64.0f); const float var = fmaxf(D2[i] * (1.0f / 64.0f) - m * m, 0.f); R[i] = __builtin_amdgcn_rsqf(var + GN_EPS); NB[i] = -m * R[i]; }
            const f32x2 lnw2 = {lnw, lnw}, lnb2 = {lnb, lnb};
#pragma unroll
            for (int j = 0; j < 8; j += 2) { const int t = tlo + j; const int src0 = j + 32 * ((j >> 2) & 1);
                const float r0 = R[j & 3], r1 = R[(j + 1) & 3], n0 = NB[j & 3], n1 = NB[(j + 1) & 3];
                const f32x2 rs = {__builtin_bit_cast(float, __builtin_amdgcn_readlane(__builtin_bit_cast(int, r0), src0)), __builtin_bit_cast(float, __builtin_amdgcn_readlane(__builtin_bit_cast(int, r1), src0 + 1))};
                const f32x2 nb = {__builtin_bit_cast(float, __builtin_amdgcn_readlane(__builtin_bit_cast(int, n0), src0)), __builtin_bit_cast(float, __builtin_amdgcn_readlane(__builtin_bit_cast(int, n1), src0 + 1))};
                const f32x2 o = {bf2f(*(const LAS unsigned short*)(ob + t * PQ + 2 * lane)), bf2f(*(const LAS unsigned short*)(ob + (t + 1) * PQ + 2 * lane))};
                const f32x2 vv = {bf2f(*(const LAS unsigned short*)(cV + t * PQ + 2 * lane)), bf2f(*(const LAS unsigned short*)(cV + (t + 1) * PQ + 2 * lane))};
                const f32x2 gg = {bf2f(*(const LAS unsigned short*)(cG + t * PQ + 2 * lane)), bf2f(*(const LAS unsigned short*)(cG + (t + 1) * PQ + 2 * lane))};
                const f32x2 rk2 = {RK[t], RK[t + 1]};
                const f32x2 A = rs * lnw2, B = nb * lnw2 + lnb2;
                f32x2 x = o * A + B; x = rk2 * vv + x; x = x * gg;
                x = x * 4.0f; x[0] = __builtin_amdgcn_fmed3f(x[0], -448.0f, 448.0f); x[1] = __builtin_amdgcn_fmed3f(x[1], -448.0f, 448.0f);
                const unsigned pk = pk4_fp8(x[0], x[0], x[1], x[1]);
                *(GAS unsigned char*)(RWO8 + (size_t)(tg + t) * 1024 + 64 * hd + lane) = (unsigned char)(pk & 0xffu);
                *(GAS unsigned char*)(RWO8 + (size_t)(tg + t + 1) * 1024 + 64 * hd + lane) = (unsigned char)((pk >> 16) & 0xffu); } };
        if (w >= 4) {
            const int pw = w - 4;
            LAS unsigned char* sb = SBb + pw * SBUF;
            int ln0_ = lane_now();
            auto dma = [&](int c, const bf16* bA, int pA, int cA, const bf16* bB, int pB, int cB, bool bnoshift, int ln) {
                int cc_ = c; asm volatile("" : "+s"(cc_));
                const int t0 = b * SEQ + cc_ * CH; const int tt0 = ln >> 4, pc = ln & 15; const bool isB = pc >= 8;
                const bf16* base = isB ? bB : bA; const int pitch = isB ? pB : pA; const int col = isB ? (cB + 8 * (pc - 8)) : (cA + 8 * pc);
                const int row0 = (isB && bnoshift) ? (t0 + tt0) : (t0 - 1 + tt0);
                const bf16* s0 = base + (size_t)row0 * pitch + col; const size_t rstep = (size_t)4 * pitch;
#pragma unroll
                for (int k = 0; k < 8; ++k) __builtin_amdgcn_global_load_lds((const unsigned*)(s0 + k * rstep), (LAS unsigned*)(sb + k * 1024), 16, 0, 0);
                const bf16* s8 = base + (size_t)(t0 + 31) * pitch + col;
                __builtin_amdgcn_global_load_lds((const unsigned*)s8, (LAS unsigned*)(sb + 8 * 1024), 16, 0, 0); };
            const bf16* LI = (const bf16*)(F.ws + WS_LI);
            const bool cv_on = cv_in_scan(F.G) && (bh == F.bid);
            const int cv_wid = F.bid * 4 + pw, cv_nw = F.G * 4;
            LAS unsigned char* cvb = CVb + pw * CVB;
            auto cv_issue = [&](int j, int ln) {
                const int it = j * cv_nw + cv_wid;
                if (cv_on && it < CV_ITEMS) {
                    const bool is1 = it < 65536; const int r_ = is1 ? it : it - 65536;
                    const int e = is1 ? (r_ >> 11) : (r_ >> 10), rem = is1 ? (r_ & 2047) : (r_ & 1023), kb = is1 ? (rem >> 5) : (rem >> 4), nb = is1 ? (rem & 31) : (rem & 15), N = is1 ? 2048 : 1024;
                    const float* s0 = (is1 ? inptr(IN_EW1) : inptr(IN_EW2)) + ((size_t)(l * NE + e) * 1024 + kb * 16 + (ln >> 4)) * N + nb * 64 + 4 * (ln & 15);
#pragma unroll
                    for (int k = 0; k < 4; ++k) __builtin_amdgcn_global_load_lds((const unsigned*)(s0 + (size_t)(4 * k) * N), (LAS unsigned*)(cvb + k * 1024), 16, 0, 0);
                } };
            auto cv_step = [&](int j, int ln) {
                const int it = j * cv_nw + cv_wid;
                if (cv_on && it < CV_ITEMS) {
                    const bool is1 = it < 65536; const int r_ = is1 ? it : it - 65536;
                    const int e = is1 ? (r_ >> 11) : (r_ >> 10), rem = is1 ? (r_ & 2047) : (r_ & 1023), kb = is1 ? (rem >> 5) : (rem >> 4), nb = is1 ? (rem & 31) : (rem & 15), N = is1 ? 2048 : 1024;
                    unsigned char* dst = F.ws + (is1 ? WS_W1 : WS_W2) + ((size_t)e * N + nb * 64 + ln) * 1024 + kb * 16;
                    const float sc = is1 ? 32.0f : 64.0f;
                    f32x2 v[8];
#pragma unroll
                    for (int kk = 0; kk < 8; ++kk) v[kk] = (f32x2){*(const LAS float*)(cvb + (2 * kk) * 256 + ln * 4), *(const LAS float*)(cvb + (2 * kk + 1) * 256 + ln * 4)} * sc;
                    u32x4 o; o.x = pk4_fp8(v[0][0], v[0][1], v[1][0], v[1][1]); o.y = pk4_fp8(v[2][0], v[2][1], v[3][0], v[3][1]); o.z = pk4_fp8(v[4][0], v[4][1], v[5][0], v[5][1]); o.w = pk4_fp8(v[6][0], v[6][1], v[7][0], v[7][1]);
                    *(GAS u32x4*)dst = o;
                    asm volatile("s_waitcnt lgkmcnt(0)" ::: "memory");
                    __builtin_amdgcn_sched_barrier(0);
                }
                cv_issue(j + 1, ln); };
            auto clear_prev = [&](bool first, int ln, int byte_lo) { if (first) { unsigned z_ = 0u; asm volatile("" : "+v"(z_)); if (ln < 8) *(LAS u32x4*)(sb + byte_lo + ln * 16) = (u32x4){z_, z_, z_, z_}; asm volatile("s_waitcnt lgkmcnt(0)" ::: "memory"); } };
            auto afrag_sb = [&](int r, int cb) -> bf16x8 { return *(const LAS bf16x8*)(sb + (r + 1) * 256 + cb); };
            auto shift16 = [&](int cb, float muc, int h, float (&o)[16]) {
#pragma unroll
                for (int i = 0; i < 16; i += 2) { const int t = crow(i, h);
                    const float x0 = bf2f(*(const LAS unsigned short*)(sb + t * 256 + cb)), x1 = bf2f(*(const LAS unsigned short*)(sb + (t + 1) * 256 + cb)), x2 = bf2f(*(const LAS unsigned short*)(sb + (t + 2) * 256 + cb));
                    const f32x2 cu = {x1, x2}, pv = {x0, x1}; const f32x2 q = cu + (pv - cu) * muc; o[i] = q[0]; o[i + 1] = q[1]; } };
            bf16x8 Bq[16];
            auto bload = [&](size_t lo_off, int km, int nks, int r, int h, int nb_lo = 0, int nb_hi = 2) {
#pragma unroll
                for (int nb = 0; nb < 2; ++nb) if (nb >= nb_lo && nb < nb_hi)
#pragma unroll
                    for (int ks = 0; ks < 8; ++ks) if (ks < nks) Bq[nb * nks + ks] = *(const GAS bf16x8*)(lora + lo_off / 2 + (size_t)(64 * hd + 32 * nb + r) * km + 16 * ks + 8 * h); };
            { int ln = lane_now(); dma(pw, LI, 256, 64, P, IN_COLS, C_RK + 64 * hd, false, ln); cv_issue(0, ln); bload(LO_A2, 64, 4, ln & 31, ln >> 5); }
            for (int i = 0; i < pw; ++i) bar_lds();
            for (int c = pw; c < NCHK; c += 4) {
                const int t0 = b * SEQ + c * CH; const bool first = (c == 0);
                LAS unsigned char* gs = GS + (c & 1) * GSLOT; LAS unsigned char* cAt = gs; LAS unsigned char* cRt = gs + 32 * PB; LAS unsigned char* cBt = gs + 64 * PB; LAS unsigned char* cKt = gs + 96 * PB; LAS float* GC = (LAS float*)(gs + 128 * PB);
                LAS unsigned char* ps = PS + (c & 3) * PSLOT; LAS unsigned char* cV = ps; LAS unsigned char* cG = ps + 32 * PQ; LAS float* RK = (LAS float*)(ps + 64 * PQ);
                int r, h, ln;
                { ln = lane_now(); r = ln & 31; h = ln >> 5; }
                unsigned apk[2][8], bpk[2][8], kpk[2][8];
                asm volatile("s_waitcnt vmcnt(0)" ::: "memory");
                cv_step(4 * (c >> 2) + 0, ln);
                clear_prev(first, ln, 128);
                {
                    f32x16 acc0 = zero16(), acc1 = zero16();
#pragma unroll
                    for (int ks = 0; ks < 4; ++ks) { const bf16x8 af = afrag_sb(r, (16 * ks + 8 * h) * 2); acc0 = MFMA32(af, Bq[ks], acc0); acc1 = MFMA32(af, Bq[4 + ks], acc1); }
                    float ksv[2][16], ss[16];
                    shift16(128 + 2 * r, CT[448 + r], h, ksv[0]); shift16(128 + 2 * (32 + r), CT[480 + r], h, ksv[1]);
                    const float kkc[2] = {CT[192 + r], CT[224 + r]}, kac[2] = {CT[256 + r], CT[288 + r]}, a0c[2] = {CT[64 + r], CT[96 + r]};
#pragma unroll
                    for (int i = 0; i < 16; ++i) asm volatile("" : "+v"(ksv[0][i]), "+v"(ksv[1][i]));
                    asm volatile("s_waitcnt lgkmcnt(0)" ::: "memory");
                    __builtin_amdgcn_sched_barrier(0);
                    dma(c, LI, 256, 0, P, IN_COLS, C_R + 64 * hd, false, ln);
#pragma unroll
                    for (int i = 0; i < 16; ++i) asm volatile("" : "+v"(acc0[i]), "+v"(acc1[i]));
                    bload(LO_W2, 64, 4, r, h);
                    __builtin_amdgcn_sched_barrier(0);
                    unsigned alp[2][8];
#pragma unroll
                    for (int i = 0; i < 8; ++i) { const float b0 = -1.44269504f * a0c[0], b1 = -1.44269504f * a0c[1];
                        const f32x2 s0 = sigmoid2_l2((f32x2){acc0[2 * i], acc0[2 * i + 1]} * -1.44269504f + b0), s1 = sigmoid2_l2((f32x2){acc1[2 * i], acc1[2 * i + 1]} * -1.44269504f + b1);
                        alp[0][i] = pk2(s0[0], s0[1]); alp[1][i] = pk2(s1[0], s1[1]); asm volatile("" : "+v"(alp[0][i]), "+v"(alp[1][i])); }
#pragma unroll
                    for (int i = 0; i < 16; i += 2) { const f32x2 ka = (f32x2){ksv[0][i], ksv[0][i + 1]} * kkc[0], kb = (f32x2){ksv[1][i], ksv[1][i + 1]} * kkc[1]; const f32x2 q = ka * ka + kb * kb; ss[i] = q[0]; ss[i + 1] = q[1]; }
#pragma unroll
                    for (int i = 0; i < 16; ++i) ss[i] = fminf(__builtin_amdgcn_rsqf(half_sum(ss[i], h)), 1e12f);
#pragma unroll
                    for (int nb = 0; nb < 2; ++nb)
#pragma unroll
                        for (int i = 0; i < 8; ++i) { const f32x2 k = {ksv[nb][2 * i], ksv[nb][2 * i + 1]}, av = {bflo(alp[nb][i]), bfhi(alp[nb][i])}, sp = {ss[2 * i], ss[2 * i + 1]};
                            const f32x2 n = (k * kkc[nb]) * sp, bn = n * av, kf = k * (av * kac[nb] + (1.0f - kac[nb]));
                            apk[nb][i] = pk2(-n[0], -n[1]); bpk[nb][i] = pk2(bn[0], bn[1]); kpk[nb][i] = pk2(kf[0], kf[1]);
                            asm volatile("" : "+v"(apk[nb][i]), "+v"(bpk[nb][i]), "+v"(kpk[nb][i])); }
                }
                bar_lds();
                { ln = lane_now(); r = ln & 31; h = ln >> 5; }
                float rk[16]; unsigned atp[2][8], rtp[2][8], btp[2][8], ktp[2][8], gcp;
                asm volatile("s_waitcnt vmcnt(0)" ::: "memory");
                cv_step(4 * (c >> 2) + 1, ln);
                clear_prev(first, ln, 128);
                {
                    f32x16 acc0 = zero16(), acc1 = zero16();
#pragma unroll
                    for (int ks = 0; ks < 4; ++ks) { const bf16x8 af = afrag_sb(r, (16 * ks + 8 * h) * 2); acc0 = MFMA32(af, Bq[ks], acc0); acc1 = MFMA32(af, Bq[4 + ks], acc1); }
                    float rsv[2][16];
                    shift16(128 + 2 * r, CT[384 + r], h, rsv[0]); shift16(128 + 2 * (32 + r), CT[416 + r], h, rsv[1]);
#pragma unroll
                    for (int i = 0; i < 16; ++i) asm volatile("" : "+v"(rsv[0][i]), "+v"(rsv[1][i]));
                    asm volatile("s_waitcnt lgkmcnt(0)" ::: "memory");
                    __builtin_amdgcn_sched_barrier(0);
                    dma(c, LI, 256, 128, LI, 256, 192, false, ln);
                    __builtin_amdgcn_sched_barrier(0);
                    float gcv[2];
#pragma unroll
                    for (int nb = 0; nb < 2; ++nb) { const float w0c_ = CT[32 * nb + r], rkc_ = CT[320 + 32 * nb + r];
                        float wd[16];
#pragma unroll
                        for (int i = 0; i < 16; i += 2) { const float bw = -1.44269504f * w0c_;
                            const f32x2 sg = sigmoid2_l2((nb ? (f32x2){acc1[i], acc1[i + 1]} : (f32x2){acc0[i], acc0[i + 1]}) * -1.44269504f + bw) * (-0.60653066f * 1.44269504f);
                            wd[i] = __builtin_amdgcn_exp2f(sg[0]); wd[i + 1] = __builtin_amdgcn_exp2f(sg[1]); }
                        float sp4[4], so4[4];
#pragma unroll
                        for (int g = 0; g < 4; ++g) { sp4[g] = (wd[4 * g] * wd[4 * g + 1]) * (wd[4 * g + 2] * wd[4 * g + 3]); so4[g] = shx(sp4[g], 32, ln); }
                        float run = 1.0f, gex[16];
#pragma unroll
                        for (int g = 0; g < 4; ++g) { const float p0 = h ? so4[g] : sp4[g], p1 = h ? sp4[g] : so4[g]; float x = h ? run * p0 : run; run = run * p0 * p1;
#pragma unroll
                            for (int e = 0; e < 4; ++e) { gex[4 * g + e] = x; x *= wd[4 * g + e]; } }
                        gcv[nb] = run;
#pragma unroll
                        for (int i = 0; i < 8; ++i) { const f32x2 gx = {gex[2 * i], gex[2 * i + 1]}; const f32x2 g = gx * (f32x2){wd[2 * i], wd[2 * i + 1]}; const f32x2 iv = {__builtin_amdgcn_rcpf(g[0]), __builtin_amdgcn_rcpf(g[1])};
                            const f32x2 kp = {bflo(kpk[nb][i]), bfhi(kpk[nb][i])}, rv = {rsv[nb][2 * i], rsv[nb][2 * i + 1]};
                            const f32x2 q = (rv * kp) * rkc_;
                            const f32x2 rkn = nb ? (f32x2){rk[2 * i], rk[2 * i + 1]} + q : q; rk[2 * i] = rkn[0]; rk[2 * i + 1] = rkn[1];
                            const f32x2 at = (f32x2){bflo(apk[nb][i]), bfhi(apk[nb][i])} * gx, rt = rv * g, bt = (f32x2){bflo(bpk[nb][i]), bfhi(bpk[nb][i])} * iv, kt = kp * iv;
                            atp[nb][i] = pk2(at[0], at[1]); rtp[nb][i] = pk2(rt[0], rt[1]); btp[nb][i] = pk2(bt[0], bt[1]); ktp[nb][i] = pk2(kt[0], kt[1]);
                            asm volatile("" : "+v"(atp[nb][i]), "+v"(rtp[nb][i]), "+v"(btp[nb][i]), "+v"(ktp[nb][i])); }
                        __builtin_amdgcn_sched_barrier(0); }
                    gcp = pk2(gcv[0], gcv[1]); asm volatile("" : "+v"(gcp));
#pragma unroll
                    for (int i = 0; i < 16; ++i) asm volatile("" : "+v"(rk[i]));
                }
                bar_lds();
                { ln = lane_now(); r = ln & 31; h = ln >> 5; }
                unsigned gpk[2][8];
                bload(LO_G2, 128, 8, r, h);
                asm volatile("s_waitcnt vmcnt(0)" ::: "memory");
                cv_step(4 * (c >> 2) + 2, ln);
                {
                    f32x16 acc0 = zero16(), acc1 = zero16();
#pragma unroll
                    for (int ks = 0; ks < 8; ++ks) { const bf16x8 af = afrag_sb(r, (16 * ks + 8 * h) * 2); acc0 = MFMA32(af, Bq[ks], acc0); acc1 = MFMA32(af, Bq[8 + ks], acc1); }
                    asm volatile("s_waitcnt lgkmcnt(0)" ::: "memory");
                    __builtin_amdgcn_sched_barrier(0);
                    dma(c, P, IN_COLS, C_RV + 64 * hd, (l > 0) ? (const bf16*)VF : P, (l > 0) ? 1024 : IN_COLS, (l > 0) ? 64 * hd : C_RV + 64 * hd, l > 0, ln);
#pragma unroll
                    for (int i = 0; i < 8; ++i) { gpk[0][i] = pk2(acc0[2 * i], acc0[2 * i + 1]); gpk[1][i] = pk2(acc1[2 * i], acc1[2 * i + 1]); asm volatile("" : "+v"(gpk[0][i]), "+v"(gpk[1][i])); }
                    if (l > 0) bload(LO_V2, 32, 2, r, h);
                    __builtin_amdgcn_sched_barrier(0);
#pragma unroll
                    for (int i = 0; i < 16; ++i) { rk[i] = half_sum(rk[i], h); asm volatile("" : "+v"(rk[i])); }
                }
                bar_lds();
                { ln = lane_now(); r = ln & 31; h = ln >> 5; }
                bf16x8 avf[2] = {(bf16x8){0, 0, 0, 0, 0, 0, 0, 0}, (bf16x8){0, 0, 0, 0, 0, 0, 0, 0}};
                if (l > 0) { avf[0] = *(const GAS bf16x8*)(VLi + (size_t)(t0 + r) * 32 + 8 * h); avf[1] = *(const GAS bf16x8*)(VLi + (size_t)(t0 + r) * 32 + 16 + 8 * h); }
                asm volatile("s_waitcnt vmcnt(0)" ::: "memory");
                cv_step(4 * (c >> 2) + 3, ln);
                clear_prev(first, ln, 0);
                {
                    asm volatile("" : "+v"(avf[0]), "+v"(avf[1]));
                    f32x16 av0 = zero16(), av1 = zero16();
                    if (l > 0) { av0 = MFMA32(avf[0], Bq[0], av0); av0 = MFMA32(avf[1], Bq[1], av0); av1 = MFMA32(avf[0], Bq[2], av1); av1 = MFMA32(avf[1], Bq[3], av1); }
                    float vs[2][16]; unsigned vfp[2][8];
#pragma unroll
                    for (int nb = 0; nb < 2; ++nb) { const int cb = 2 * (32 * nb + r); shift16(cb, CT[512 + 32 * nb + r], h, vs[nb]);
#pragma unroll
                        for (int i = 0; i < 8; ++i) { vfp[nb][i] = 0u; if (l > 0) vfp[nb][i] = (unsigned)*(const LAS unsigned short*)(sb + crow(2 * i, h) * 256 + 128 + cb) | ((unsigned)*(const LAS unsigned short*)(sb + crow(2 * i + 1, h) * 256 + 128 + cb) << 16); } }
#pragma unroll
                    for (int i = 0; i < 16; ++i) asm volatile("" : "+v"(vs[0][i]), "+v"(vs[1][i]));
#pragma unroll
                    for (int i = 0; i < 8; ++i) asm volatile("" : "+v"(vfp[0][i]), "+v"(vfp[1][i]));
                    asm volatile("s_waitcnt lgkmcnt(0)" ::: "memory");
                    __builtin_amdgcn_sched_barrier(0);
                    if (c + 4 < NCHK) dma(c + 4, LI, 256, 64, P, IN_COLS, C_RK + 64 * hd, false, ln);
#pragma unroll
                    for (int i = 0; i < 16; ++i) asm volatile("" : "+v"(av0[i]), "+v"(av1[i]));
                    __builtin_amdgcn_sched_barrier(0);
#pragma unroll
                    for (int nb = 0; nb < 2; ++nb) { const int cb = 2 * (32 * nb + r); const float v0c_ = CT[128 + 32 * nb + r];
                        if (l == 0) {
#pragma unroll
                            for (int i = 0; i < 16; ++i) *(GAS unsigned short*)(VF + (size_t)(t0 + crow(i, h)) * 1024 + 64 * hd + 32 * nb + r) = (unsigned short)(pk2(vs[nb][i], vs[nb][i]) & 0xffffu);
                        } else {
#pragma unroll
                            for (int i = 0; i < 16; ++i) { const float vf = (i & 1) ? bfhi(vfp[nb][i >> 1]) : bflo(vfp[nb][i >> 1]); vs[nb][i] = vs[nb][i] + (vf - vs[nb][i]) * sigmoidf_(v0c_ + (nb ? av1[i] : av0[i])); }
                        }
#pragma unroll
                        for (int i = 0; i < 8; ++i) { const int ta = crow(2 * i, h), tb = crow(2 * i + 1, h); const unsigned vp = pk2(vs[nb][2 * i], vs[nb][2 * i + 1]);
                            *(LAS unsigned short*)(cV + ta * PQ + cb) = (unsigned short)(vp & 0xffffu); *(LAS unsigned short*)(cV + tb * PQ + cb) = (unsigned short)(vp >> 16);
                            *(LAS unsigned short*)(cG + ta * PQ + cb) = (unsigned short)(gpk[nb][i] & 0xffffu); *(LAS unsigned short*)(cG + tb * PQ + cb) = (unsigned short)(gpk[nb][i] >> 16);
                            *(LAS unsigned short*)(cAt + ta * PB + cb) = (unsigned short)(atp[nb][i] & 0xffffu); *(LAS unsigned short*)(cAt + tb * PB + cb) = (unsigned short)(atp[nb][i] >> 16);
                            *(LAS unsigned short*)(cRt + ta * PB + cb) = (unsigned short)(rtp[nb][i] & 0xffffu); *(LAS unsigned short*)(cRt + tb * PB + cb) = (unsigned short)(rtp[nb][i] >> 16);
                            *(LAS unsigned short*)(cBt + ta * PB + cb) = (unsigned short)(btp[nb][i] & 0xffffu); *(LAS unsigned short*)(cBt + tb * PB + cb) = (unsigned short)(btp[nb][i] >> 16);
                            *(LAS unsigned short*)(cKt + ta * PB + cb) = (unsigned short)(ktp[nb][i] & 0xffffu); *(LAS unsigned short*)(cKt + tb * PB + cb) = (unsigned short)(ktp[nb][i] >> 16); }
                        if (h == 0) GC[32 * nb + r] = nb ? bfhi(gcp) : bflo(gcp); }
                    if (r == 0) {
#pragma unroll
                        for (int i = 0; i < 16; ++i) RK[crow(i, h)] = rk[i];
                    }
                }
                if (c + 4 < NCHK) bload(LO_A2, 64, 4, r, h);
                bar_lds();
            }
            for (int i = pw + 4 * (NCHK / 4); i < NP; ++i) bar_lds();
        } else if (w >= 2) {
            const int ib = w - 2;
            float lnw, lnb; { const int ln0_ = lane_now(); lnw = inptr(IN_LNXW)[l * 1024 + 64 * hd + ln0_]; lnb = inptr(IN_LNXB)[l * 1024 + 64 * hd + ln0_]; }
            f32x16 ST0 = zero16(), ST1 = zero16(), VUo = zero16(), WT0 = zero16(), WT1 = zero16();
            bf16x8 idf[2]; { const int ln0_ = lane_now(); identity_frags(ln0_ & 31, ln0_ >> 5, idf); }
            auto s_period = [&](int p, auto ALL_) { constexpr bool ALL = decltype(ALL_)::value;
                int ln = lane_now();
                const int lane = ln, r = ln & 31, h = ln >> 5;
                const int cs = p - 5, cl = p - 4;
                if (ALL || (cs >= 0 && cs < NCHK)) {
                    LAS unsigned char* cQo = QB + (cs & 1) * QBUF; LAS unsigned char* cQs = cQo + 32 * PQ; LAS unsigned char* ob = OB + (cs & 1) * OBUF;
                    const bf16x8 s00 = packacc(ST0, 0), s01 = packacc(ST0, 1), s10 = packacc(ST1, 0), s11 = packacc(ST1, 1);
                    f32x16 O = VUo;
                    O = MFMA32(frag_row_perm(cQo, PQ, r, 0, h), s00, O); O = MFMA32(frag_row_perm(cQo, PQ, r, 16, h), s01, O);
                    O = MFMA32(frag_row_perm(cQo, PQ, r, 32, h), s10, O); O = MFMA32(frag_row_perm(cQo, PQ, r, 48, h), s11, O);
                    f32x16 n0 = WT0, n1 = WT1;
                    n0 = MFMA32(frag_row_perm(cQs, PQ, r, 0, h), s00, n0); n0 = MFMA32(frag_row_perm(cQs, PQ, r, 16, h), s01, n0);
                    n0 = MFMA32(frag_row_perm(cQs, PQ, r, 32, h), s10, n0); n0 = MFMA32(frag_row_perm(cQs, PQ, r, 48, h), s11, n0);
                    n1 = MFMA32(frag_row_perm(cQs, PQ, 32 + r, 0, h), s00, n1); n1 = MFMA32(frag_row_perm(cQs, PQ, 32 + r, 16, h), s01, n1);
                    n1 = MFMA32(frag_row_perm(cQs, PQ, 32 + r, 32, h), s10, n1); n1 = MFMA32(frag_row_perm(cQs, PQ, 32 + r, 48, h), s11, n1);
                    ST0 = n0; ST1 = n1;
#pragma unroll
                    for (int i = 0; i < 16; i += 2) { const unsigned pk = pk2(O[i], O[i + 1]);
                        *(LAS unsigned short*)(ob + crow(i, h) * PQ + 2 * (32 * ib + r)) = (unsigned short)(pk & 0xffffu); *(LAS unsigned short*)(ob + crow(i + 1, h) * PQ + 2 * (32 * ib + r)) = (unsigned short)(pk >> 16); }
                }
                if (ALL || (cl >= 0 && cl < NCHK)) {
                    LAS unsigned char* gs = GS + (cl & 1) * GSLOT; LAS unsigned char* cAt = gs; LAS unsigned char* cRt = gs + 32 * PB; LAS unsigned char* cBt = gs + 64 * PB; LAS unsigned char* cKt = gs + 96 * PB; LAS float* GC = (LAS float*)(gs + 128 * PB);
                    LAS unsigned char* cV = PS + (cl & 3) * PSLOT;
                    f32x16 N = gram(cBt, cAt, PB, r, h), L = gram(cAt, cBt, PB, r, h), Mbr = gram(cBt, cRt, PB, r, h), Mkr = gram(cKt, cRt, PB, r, h), Y = gram(cAt, cKt, PB, r, h);
#pragma unroll
                    for (int i = 0; i < 16; ++i) { const int rw = crow(i, h); N[i] = (rw < r) ? N[i] : 0.f; L[i] = (rw > r) ? L[i] : 0.f; Mbr[i] = (rw <= r) ? Mbr[i] : 0.f; Mkr[i] = (rw <= r) ? Mkr[i] : 0.f; Y[i] = (rw > r) ? Y[i] : 0.f; }
#pragma unroll
                    for (int st = 0; st < 5; ++st) { Y = mm_tt(N, Y, Y); if (st < 4) { const f32x16 Nn = mm_tt(L, N, zero16()), Ln = mm_tt(N, L, zero16()); N = Nn; L = Ln; } }
                    const f32x16 Uo = mm_tt(Y, Mbr, Mkr);
                    const bf16x8 y0 = packacc(Y, 0), y1 = packacc(Y, 1);
                    f32x16 Us0 = acc_by_mfma(cKt, PB, 0, 0, r, h, idf), Us1 = acc_by_mfma(cKt, PB, 0, 32, r, h, idf);
                    Us0 = MFMA32(y0, frag_tr(cBt, PB, 0, 0, lane), Us0); Us0 = MFMA32(y1, frag_tr(cBt, PB, 16, 0, lane), Us0);
                    Us1 = MFMA32(y0, frag_tr(cBt, PB, 0, 32, lane), Us1); Us1 = MFMA32(y1, frag_tr(cBt, PB, 16, 32, lane), Us1);
                    const float g0 = GC[r], g1 = GC[32 + r];
#pragma unroll
                    for (int i = 0; i < 16; ++i) { Us0[i] *= g0; Us1[i] *= g1; }
                    const bf16x8 v0f = frag_tr(cV, PQ, 0, 32 * ib, lane), v1f = frag_tr(cV, PQ, 16, 32 * ib, lane);
                    VUo = MFMA32(packacc(Uo, 0), v0f, zero16()); VUo = MFMA32(packacc(Uo, 1), v1f, VUo);
                    WT0 = MFMA32(packacc(Us0, 0), v0f, zero16()); WT0 = MFMA32(packacc(Us0, 1), v1f, WT0);
                    WT1 = MFMA32(packacc(Us1, 0), v0f, zero16()); WT1 = MFMA32(packacc(Us1, 1), v1f, WT1);
                }
                { const int cp = p - 6; if (ALL || (cp >= 0 && cp < NCHK)) post_tokens(cp, 16 + 8 * ib, lane, lnw, lnb); }
                bar_lds();
            };
            for (int p = 0; p < NP; ++p) { if (p >= 6 && p < NCHK + 4) s_period(p, std::true_type{}); else s_period(p, std::false_type{}); }
        } else {
            const int jb = w;
            int ln0_ = lane_now();
            const float lnw = inptr(IN_LNXW)[l * 1024 + 64 * hd + ln0_], lnb = inptr(IN_LNXB)[l * 1024 + 64 * hd + ln0_];
            bf16x8 idf[2]; identity_frags(ln0_ & 31, ln0_ >> 5, idf);
            auto y_period = [&](int p, auto ALL_) { constexpr bool ALL = decltype(ALL_)::value;
                int ln = lane_now();
                const int lane = ln, r = ln & 31, h = ln >> 5;
                const int cl = p - 4, cp = p - 6;
                if (ALL || (cl >= 0 && cl < NCHK)) {
                    LAS unsigned char* gs = GS + (cl & 1) * GSLOT; LAS unsigned char* cAt = gs; LAS unsigned char* cRt = gs + 32 * PB; LAS unsigned char* cBt = gs + 64 * PB; LAS float* GC = (LAS float*)(gs + 128 * PB);
                    LAS unsigned char* cQo = QB + (cl & 1) * QBUF; LAS unsigned char* cQs = cQo + 32 * PQ;
                    f32x16 N = gram(cBt, cAt, PB, r, h), L = gram(cAt, cBt, PB, r, h), Mbr = gram(cBt, cRt, PB, r, h);
#pragma unroll
                    for (int i = 0; i < 16; ++i) { const int rw = crow(i, h); N[i] = (rw < r) ? N[i] : 0.f; L[i] = (rw > r) ? L[i] : 0.f; Mbr[i] = (rw <= r) ? Mbr[i] : 0.f; }
                    f32x16 Y = acc_from_tr(cAt, PB, 0, 32 * jb, lane);
#pragma unroll
                    for (int st = 0; st < 5; ++st) { Y = mm_tt(N, Y, Y); if (st < 4) { const f32x16 Nn = mm_tt(L, N, zero16()), Ln = mm_tt(N, L, zero16()); N = Nn; L = Ln; } }
                    f32x16 Q = acc_by_mfma(cRt, PB, 0, 32 * jb, r, h, idf); Q = mm_tt(Mbr, Y, Q);
#pragma unroll
                    for (int i = 0; i < 16; i += 2) { const unsigned pk = pk2(Q[i], Q[i + 1]);
                        *(LAS unsigned short*)(cQo + crow(i, h) * PQ + 2 * (32 * jb + r)) = (unsigned short)(pk & 0xffffu); *(LAS unsigned short*)(cQo + crow(i + 1, h) * PQ + 2 * (32 * jb + r)) = (unsigned short)(pk >> 16); }
                    const bf16x8 y0 = packacc(Y, 0), y1 = packacc(Y, 1);
#pragma unroll
                    for (int j2 = 0; j2 < 2; ++j2) { f32x16 q2;
#pragma unroll
                        for (int i = 0; i < 16; ++i) q2[i] = (j2 == jb && crow(i, h) == r) ? 1.0f : 0.f;
                        q2 = MFMA32(frag_tr(cBt, PB, 0, 32 * j2, lane), y0, q2); q2 = MFMA32(frag_tr(cBt, PB, 16, 32 * j2, lane), y1, q2);
#pragma unroll
                        for (int i = 0; i < 16; i += 2) { const f32x2 q = (f32x2){q2[i], q2[i + 1]} * (f32x2){GC[32 * j2 + crow(i, h)], GC[32 * j2 + crow(i + 1, h)]}; const unsigned pk = pk2(q[0], q[1]);
                            *(LAS unsigned short*)(cQs + (32 * j2 + crow(i, h)) * PQ + 2 * (32 * jb + r)) = (unsigned short)(pk & 0xffffu); *(LAS unsigned short*)(cQs + (32 * j2 + crow(i + 1, h)) * PQ + 2 * (32 * jb + r)) = (unsigned short)(pk >> 16); } }
                }
                if (ALL || (cp >= 0 && cp < NCHK)) post_tokens(cp, 8 * jb, lane, lnw, lnb);
                bar_lds();
            };
            for (int p = 0; p < NP; ++p) { if (p >= 6 && p < NCHK + 4) y_period(p, std::true_type{}); else y_period(p, std::false_type{}); }
        }
    }
}

#define DPP_MAXU_(v, ctrl, rm) { const unsigned t_ = (unsigned)__builtin_amdgcn_update_dpp(0, (int)(v), ctrl, rm, 0xf, false); v = v > t_ ? v : t_; }
DI unsigned half_maxu(unsigned v, int h) {
    DPP_MAXU_(v, 0x111, 0xf); DPP_MAXU_(v, 0x112, 0xf); DPP_MAXU_(v, 0x114, 0xf); DPP_MAXU_(v, 0x118, 0xf); DPP_MAXU_(v, 0x142, 0xa);
    const unsigned s31 = (unsigned)__builtin_amdgcn_readlane((int)v, 31), s63 = (unsigned)__builtin_amdgcn_readlane((int)v, 63);
    return h ? s63 : s31; }
DI void phase_router(Frame& F, const Args& a, int l) {
    constexpr int RPB = 2064;
    LAS unsigned char* RWH = F.lds; LAS unsigned char* RWL = F.lds + 32 * RPB; LAS float* CS = (LAS float*)(F.lds + 64 * RPB); LAS float* CE = CS + 32;
    LAS unsigned char* STG = F.lds + 64 * RPB + 256 + F.wave * 2048;
    static_assert(64 * RPB + 256 + 8 * 2048 <= LDSCTL_OFF, "router LDS");
    LAS int* CNT = (LAS int*)(F.lds + L_CNT); LAS int* BASE = (LAS int*)(F.lds + L_BASE); LAS unsigned* ASG = (LAS unsigned*)(F.lds + L_ASG);
    const float* g1 = inptr(IN_LN1G) + l * D; const float* b1 = inptr(IN_LN1B) + l * D;
    bf16* XB = (bf16*)(F.ws + WS_XB);
    unsigned* gcnt = (unsigned*)(F.ws + WS_CTL) + CW_CNT + l * 2048;
    unsigned* TOKINFO = (unsigned*)(F.ws + WS_TOKINFO); float* GATE = (float*)(F.ws + WS_GATE); int* TOKLIST = (int*)(F.ws + WS_TOKLIST);
    const int lane = F.lane, w = F.wave, r = lane & 31, h = lane >> 5;
    __syncthreads();
    for (int i = F.tid; i < 2 * NE * 128; i += 512) { const int row = i >> 7, c16 = i & 127;
        *(LAS u32x4*)(F.lds + row * RPB + c16 * 16) = *(const GAS u32x4*)(F.ws + WS_RIMG + (size_t)row * 2048 + c16 * 16); }
    if (F.tid < 64) CS[F.tid] = ((const GAS float*)(F.ws + WS_RIMG + 2 * NE * D * 2))[F.tid];
    f32x4 gg[4], bb[4];
#pragma unroll
    for (int j = 0; j < 4; ++j) { gg[j] = *(const GAS f32x4*)(g1 + 4 * lane + 256 * j); bb[j] = *(const GAS f32x4*)(b1 + 4 * lane + 256 * j); }
    for (int rbk = F.bid; rbk < T / 256; rbk += F.G) {
        if (F.tid < 32) CNT[F.tid] = 0;
        __syncthreads();
        const int tok0 = rbk * 256 + w * 32;
        const bf16* src = XB + (size_t)(tok0 + (lane >> 2)) * D + 8 * (lane & 3);
        u32x4 c0 = *(const GAS u32x4*)src, c1 = *(const GAS u32x4*)(src + 16 * D);
        f32x16 acc = zero16(), acc1 = zero16();
        float s1 = 0.f, s2 = 0.f;
#pragma unroll 2
        for (int ch = 0; ch < 32; ++ch) {
            u32x4 n0 = c0, n1 = c1;
            if (ch + 1 < 32) { n0 = *(const GAS u32x4*)(src + 32 * (ch + 1)); n1 = *(const GAS u32x4*)(src + 16 * D + 32 * (ch + 1)); }
            *(LAS u32x4*)(STG + lane * 16) = c0; *(LAS u32x4*)(STG + 1024 + lane * 16) = c1;
#pragma unroll
            for (int ks = 0; ks < 2; ++ks) { const u32x4 q = *(const LAS u32x4*)(STG + r * 64 + (2 * ks + h) * 16);
                const float x0 = bflo(q.x), x1 = bfhi(q.x), x2 = bflo(q.y), x3 = bfhi(q.y), x4 = bflo(q.z), x5 = bfhi(q.z), x6 = bflo(q.w), x7 = bfhi(q.w);
                s1 += ((x0 + x1) + (x2 + x3)) + ((x4 + x5) + (x6 + x7)); s2 += ((x0 * x0 + x1 * x1) + (x2 * x2 + x3 * x3)) + ((x4 * x4 + x5 * x5) + (x6 * x6 + x7 * x7));
                const int kcol = 32 * ch + 16 * ks + 8 * h;
                const bf16x8 af = __builtin_bit_cast(bf16x8, q);
                const bf16x8 bh = *(const LAS bf16x8*)(RWH + r * RPB + kcol * 2), bl = *(const LAS bf16x8*)(RWL + r * RPB + kcol * 2);
                acc = MFMA32(af, bh, acc); acc1 = MFMA32(af, bl, acc1); }
            asm volatile("s_waitcnt lgkmcnt(0)" ::: "memory");
            c0 = n0; c1 = n1;
        }
        s1 += shx(s1, 32, lane); s2 += shx(s2, 32, lane);
        const float mean = s1 * (1.f / D); const float rstd = rsqrtf(fmaxf(s2 * (1.f / D) - mean * mean, 0.f) + LN_EPS);
        const float cse = CS[r], cee = CE[r];
        unsigned key[16];
#pragma unroll
        for (int i = 0; i < 16; ++i) { const int rowi = crow(i, h); const float mi = shl(mean, rowi), ri = shl(rstd, rowi);
            const float lg = ri * ((acc[i] + acc1[i]) - mi * cse) + cee;
            const unsigned u = __float_as_uint(lg); const unsigned m = (u & 0x80000000u) ? ~u : (u | 0x80000000u); key[i] = (m & ~31u) | (unsigned)(31 - r); }
#pragma unroll
        for (int i = 0; i < 16; ++i) {
            unsigned mk[4];
#pragma unroll
            for (int k = 0; k < 4; ++k) { mk[k] = half_maxu(key[i], h); key[i] = (key[i] == mk[k]) ? 0u : key[i]; }
            float tv[4]; int te[4];
#pragma unroll
            for (int k = 0; k < 4; ++k) { te[k] = 31 - (int)(mk[k] & 31u); const unsigned m = mk[k] & ~31u; tv[k] = __uint_as_float((m & 0x80000000u) ? (m & 0x7fffffffu) : ~m); }
            const float e1 = __expf(tv[1] - tv[0]), e2 = __expf(tv[2] - tv[0]), e3 = __expf(tv[3] - tv[0]); const float isum = __builtin_amdgcn_rcpf(1.0f + e1 + e2 + e3);
            if (r < 4) { const int e = (r == 0) ? te[0] : ((r == 1) ? te[1] : ((r == 2) ? te[2] : te[3]));
                const float gt = ((r == 0) ? 1.0f : ((r == 1) ? e1 : ((r == 2) ? e2 : e3))) * isum;
                const int rowl = w * 32 + crow(i, h);
                const int rank = __hip_atomic_fetch_add(CNT + e, 1, __ATOMIC_RELAXED, __HIP_MEMORY_SCOPE_WORKGROUP);
                ASG[rowl * 4 + r] = ((unsigned)e << 24) | (unsigned)rank; GATE[(size_t)(rbk * 256 + rowl) * 4 + r] = gt; }
        }
        if (h == 0) *(GAS f32x2*)(F.ws + WS_STAT + (size_t)(tok0 + r) * 8) = (f32x2){mean, rstd};
#pragma unroll 2
        for (int rr = 0; rr < 32; ++rr) { const int tok = tok0 + rr;
            const float mr = __builtin_bit_cast(float, __builtin_amdgcn_readlane(__builtin_bit_cast(int, mean), rr)), sr = __builtin_bit_cast(float, __builtin_amdgcn_readlane(__builtin_bit_cast(int, rstd), rr));
            const u32x2* xb = (const u32x2*)(XB + (size_t)tok * D) + lane; unsigned* x8 = (unsigned*)(F.ws + WS_XB8 + (size_t)tok * D) + lane;
            u32x2 q[4];
#pragma unroll
            for (int j = 0; j < 4; ++j) q[j] = xb[64 * j];
#pragma unroll
            for (int j = 0; j < 4; ++j) { f32x4 v = (f32x4){bflo(q[j].x), bfhi(q[j].x), bflo(q[j].y), bfhi(q[j].y)}; v = (v - mr) * sr * gg[j] + bb[j];
                x8[64 * j] = pk4_fp8(v[0], v[1], v[2], v[3]); } }
        __syncthreads();
        if (F.tid < 32) BASE[F.tid] = (int)__hip_atomic_fetch_add(gcnt + F.tid * 64, (unsigned)CNT[F.tid], RLX_AGENT);
        __syncthreads();
        for (int idx = F.tid; idx < 1024; idx += 512) { const unsigned as = ASG[idx]; const int e = as >> 24; const int pos = BASE[e] + (int)(as & 0xffffffu); const int tokl = rbk * 256 + (idx >> 2);
            TOKINFO[(size_t)tokl * 4 + (idx & 3)] = ((unsigned)e << 24) | (unsigned)pos; TOKLIST[(size_t)e * T + pos] = tokl; }
        __syncthreads();
    }
}
DI int build_tiles(Frame& F, int l) {
    unsigned* gcnt = (unsigned*)(F.ws + WS_CTL) + CW_CNT + l * 2048;
    LAS int* CNT = (LAS int*)(F.lds + L_CNT); LAS int* TSTART = (LAS int*)(F.lds + L_TSTART);
    __syncthreads();
    if (F.tid < 32) CNT[F.tid] = (int)__hip_atomic_load(gcnt + F.tid * 64, RLX_AGENT);
    __syncthreads();
    if (F.tid == 0) { int acc = 0; for (int e = 0; e < NE; ++e) { TSTART[e] = acc; acc += (CNT[e] + 255) >> 8; } TSTART[NE] = acc; }
    __syncthreads();
    return TSTART[NE];
}
DI void phase_combine(Frame& F, const Args& a, int l) {
    (void)build_tiles(F, l);
    LAS int* TSTART = (LAS int*)(F.lds + L_TSTART);
    const float* g2 = inptr(IN_LN2G) + l * D; const float* b2 = inptr(IN_LN2B) + l * D;
    bf16* XB = (bf16*)(F.ws + WS_XB); const unsigned char* YS = (const unsigned char*)(F.ws + WS_YS);
    const unsigned* TOKINFO = (const unsigned*)(F.ws + WS_TOKINFO); const float* GATE = (const float*)(F.ws + WS_GATE);
    const int lane = F.lane;
    f32x4 gg[4], bb[4], g1a[4], b1a[4];
#pragma unroll
    for (int j = 0; j < 4; ++j) { gg[j] = *(const GAS f32x4*)(g2 + 4 * lane + 256 * j); bb[j] = *(const GAS f32x4*)(b2 + 4 * lane + 256 * j);
        g1a[j] = *(const GAS f32x4*)(inptr(IN_LN1G) + l * D + 4 * lane + 256 * j) * ALPHA; b1a[j] = *(const GAS f32x4*)(inptr(IN_LN1B) + l * D + 4 * lane + 256 * j) * ALPHA; }
    const float* STAT = (const float*)(F.ws + WS_STAT);
    const int stride = F.G * 8 * 2;
    int tok = (F.bid * 8 + F.wave) * 2;
    u32x4 tiN[2]; f32x4 gtN[2]; f32x4 stN;
#pragma unroll
    for (int q = 0; q < 2; ++q) { tiN[q] = *(const GAS u32x4*)(TOKINFO + (size_t)(tok + q) * 4); gtN[q] = *(const GAS f32x4*)(GATE + (size_t)(tok + q) * 4); }
    stN = *(const GAS f32x4*)(STAT + (size_t)tok * 2);
    for (; tok < T; tok += stride) {
        u32x4 ti[2]; f32x4 gt[2]; const f32x4 st = stN;
#pragma unroll
        for (int q = 0; q < 2; ++q) { ti[q] = tiN[q]; gt[q] = gtN[q]; }
        u32x2 xq[2][4]; unsigned yq[2][4][4];
#pragma unroll
        for (int q = 0; q < 2; ++q) { const u32x2* xb = (const u32x2*)(XB + (size_t)(tok + q) * D) + lane;
#pragma unroll
            for (int j = 0; j < 4; ++j) xq[q][j] = xb[64 * j];
#pragma unroll
            for (int k = 0; k < 4; ++k) { const unsigned inf = (k == 0) ? ti[q].x : ((k == 1) ? ti[q].y : ((k == 2) ? ti[q].z : ti[q].w));
                const int e = inf >> 24, pos = inf & 0xffffffu; const size_t slot = (size_t)TSTART[e] * 256 + pos;
                const unsigned* yr = (const unsigned*)(YS + slot * D) + lane;
#pragma unroll
                for (int j = 0; j < 4; ++j) yq[q][k][j] = yr[64 * j]; } }
        if (tok + stride < T) {
#pragma unroll
            for (int q = 0; q < 2; ++q) { tiN[q] = *(const GAS u32x4*)(TOKINFO + (size_t)(tok + stride + q) * 4); gtN[q] = *(const GAS f32x4*)(GATE + (size_t)(tok + stride + q) * 4); }
            stN = *(const GAS f32x4*)(STAT + (size_t)(tok + stride) * 2); }
#pragma unroll
        for (int q = 0; q < 2; ++q) {
            f32x4 v[4];
#pragma unroll
            for (int j = 0; j < 4; ++j) { const float sr = st[2 * q + 1], mr = -st[2 * q] * sr;
                f32x4 z = (f32x4){bflo(xq[q][j].x), bfhi(xq[q][j].x), bflo(xq[q][j].y), bfhi(xq[q][j].y)}; z = z * sr + mr; v[j] = z * g1a[j] + b1a[j]; }
#pragma unroll
            for (int k = 0; k < 4; ++k) { const float gk = gt[q][k] * 0.0625f;
#pragma unroll
                for (int j = 0; j < 4; ++j) { const f32x2 ylo = __builtin_amdgcn_cvt_pk_f32_fp8((int)yq[q][k][j], false), yhi = __builtin_amdgcn_cvt_pk_f32_fp8((int)yq[q][k][j], true);
                    v[j][0] += gk * ylo[0]; v[j][1] += gk * ylo[1]; v[j][2] += gk * yhi[0]; v[j][3] += gk * yhi[1]; } }
            float sm = 0.f;
#pragma unroll
            for (int j = 0; j < 4; ++j) sm += (v[j][0] + v[j][1]) + (v[j][2] + v[j][3]);
            const float mean = wave_sum(sm) * (1.f / D); float s2 = 0.f;
#pragma unroll
            for (int j = 0; j < 4; ++j) { v[j] = v[j] - mean; s2 += (v[j][0] * v[j][0] + v[j][1] * v[j][1]) + (v[j][2] * v[j][2] + v[j][3] * v[j][3]); }
            const float rstd = rsqrtf(wave_sum(s2) * (1.f / D) + LN_EPS);
            if (l == DEPTH - 1) { f32x4* xr = (f32x4*)(F.out + (size_t)(tok + q) * D) + lane;
#pragma unroll
                for (int j = 0; j < 4; ++j) xr[64 * j] = v[j] * rstd * gg[j] + bb[j]; }
            else { u32x2* xb = (u32x2*)(XB + (size_t)(tok + q) * D) + lane;
#pragma unroll
                for (int j = 0; j < 4; ++j) { v[j] = v[j] * rstd * gg[j] + bb[j]; u32x2 o; o.x = pk2(v[j][0], v[j][1]); o.y = pk2(v[j][2], v[j][3]); xb[64 * j] = o;
                    ((unsigned*)(F.ws + WS_XI8 + (size_t)(tok + q) * D))[lane + 64 * j] = pk4_fp8(v[j][0], v[j][1], v[j][2], v[j][3]); } }
        }
    }
}

constexpr int PH_PER_LAYER = 10, N_PHASES = DEPTH * PH_PER_LAYER;
__global__ void __launch_bounds__(512, 2) fwd_kernel(Args args) {
    extern __shared__ __attribute__((aligned(16))) unsigned char lds_raw[];
    Frame F0;
    F0.lds = (LAS unsigned char*)lds_raw;
    F0.tid = threadIdx.x; F0.lane = F0.tid & 63; F0.wave = __builtin_amdgcn_readfirstlane(F0.tid >> 6);
    F0.G = gridDim.x; F0.bid = blockIdx.x; F0.ws = args.ws; F0.out = args.out;
    volatile LAS unsigned* BARST = (volatile LAS unsigned*)(F0.lds + L_BARST);
    for (int u = F0.tid; u < (LDS_BYTES - LDSCTL_OFF) / 4; u += 512) ((LAS unsigned*)(F0.lds + LDSCTL_OFF))[u] = 0u;
    __syncthreads();
    unsigned* ctl = (unsigned*)(F0.ws + WS_CTL);
    XcdBarrier bar; bar.bar = ctl + CW_BAR; bar.x = 0; bar.st = nullptr;
    if (args.one_launch) bar = xcd_barrier_post(ctl + CW_BAR, BARST, F0.wave);
    const int lo = args.ph_lo, hi = args.ph_hi;
#define IN(k) (lo <= (k) && (k) < hi)
#define ENTER() Frame F = F0; asm volatile("" : "+s"(F.wave), "+s"(F.bid), "+s"(F.G), "+s"(F.ws), "+s"(F.out)); { unsigned z_ = 0u; asm volatile("" : "+v"(z_)); F.lane = (int)__builtin_amdgcn_mbcnt_hi(~0u, __builtin_amdgcn_mbcnt_lo(~0u, z_)); } F.tid = F.wave * 64 + F.lane; F.ws = (unsigned char*)(GAS unsigned char*)F.ws; F.out = (float*)(GAS float*)F.out; bf16* P = (bf16*)(F.ws + WS_R); (void)P
#define SEAM(k) do { if (IN(k) && IN((k) + 1)) xcd_barrier(bar, F0.wave); } while (0)
#pragma unroll
    for (int l = 0; l < DEPTH; ++l) {
        const int pb = l * PH_PER_LAYER;
        if (l == 0) {
            if (IN(pb + 0)) { ENTER(); phase_weights(F, args, l); }
            SEAM(pb + 0);
        }
        if (IN(pb + 1)) { ENTER();
            pg8::DenseSched S; S.init((const bf16*)(F.ws + WS_XI8), D, (const bf16*)(F.ws + WS_WIN), T, IN_COLS, D, F.G, F.bid, 1, 0x7F7F7F7F, 0x7A7A7A7A);
            pg8::EpiInProj E{P, (const float*)(F.ws + WS_ROPE)};
            pg8::gemm_phase<pg8::EpiInProj, pg8::DenseSched, false, true>(F.lds, F.tid, S, E);
        }
        SEAM(pb + 1);
        if (IN(pb + 2)) { ENTER(); phase_attn(F, args, l); }
        SEAM(pb + 2);
        if (IN(pb + 3)) { ENTER(); phase_scan(F, args, l); }
        SEAM(pb + 3);
        if (IN(pb + 4)) {
            { ENTER(); pg8::DenseSched S; S.init((const bf16*)(F.ws + WS_ATT8), D, (const bf16*)(F.ws + WS_WAO), T, D, D, F.G, F.bid, 1, 0x7B7B7B7B, 0x7A7A7A7A);
              pg8::EpiGate<0> E{(bf16*)(F.ws + WS_M), P + C_GA, nullptr};
              pg8::gemm_phase<pg8::EpiGate<0>, pg8::DenseSched, false, true>(F.lds, F.tid, S, E); }
            { ENTER(); pg8::DenseSched S; S.init((const bf16*)(F.ws + WS_RWO), D, (const bf16*)(F.ws + WS_WRO), T, D, D, F.G, F.bid, 1, 0x7D7D7D7D, 0x7A7A7A7A);
              pg8::EpiGate<1> E{(bf16*)(F.ws + WS_M), P + C_GR, F.ws + WS_M8};
              pg8::gemm_phase<pg8::EpiGate<1>, pg8::DenseSched, false, true>(F.lds, F.tid, S, E); }
        }
        SEAM(pb + 4);
        if (IN(pb + 5)) { ENTER();
            pg8::DenseSched S; S.init((const bf16*)(F.ws + WS_M8), D, (const bf16*)(F.ws + WS_WOUT), T, D, D, F.G, F.bid, 1, 0x7B7B7B7B, 0x7A7A7A7A);
            pg8::EpiResid E{(bf16*)(F.ws + WS_XB), (l == 0) ? inptr(IN_X) : (const float*)nullptr};
            pg8::gemm_phase<pg8::EpiResid, pg8::DenseSched, false, true>(F.lds, F.tid, S, E);
        }
        SEAM(pb + 5);
        if (IN(pb + 6)) { ENTER(); phase_router(F, args, l); }
        SEAM(pb + 6);
        if (IN(pb + 7)) { ENTER();
            const int NT = build_tiles(F, l);
            pg8::MoeSched S; S.A = (const bf16*)(F.ws + WS_XB8); S.Bt = (const bf16*)(F.ws + WS_W1); S.lda = D; S.K = D; S.npn = 8; S.NT = NT; S.nwg = NT * 8; S.G = F.G; S.c = F.bid; S.bexp = (size_t)2048 * 1024;
            S.tstart = (const LAS int*)(F.lds + L_TSTART); S.cnt = (const LAS int*)(F.lds + L_CNT); S.toklist = (const int*)(F.ws + WS_TOKLIST); S.gather = true;
            S.eb = 1; S.sA = 0x7F7F7F7F; S.sB = 0x7A7A7A7A;
            pg8::EpiSwiglu E{(bf16*)(F.ws + WS_ACT), inptr(IN_EB1) + (size_t)l * NE * 2048};
            pg8::gemm_phase<pg8::EpiSwiglu, pg8::MoeSched, true, true>(F.lds, F.tid, S, E);
        }
        SEAM(pb + 7);
        if (IN(pb + 8)) { ENTER();
            const int NT = build_tiles(F, l);
            pg8::MoeSched S; S.A = (const bf16*)(F.ws + WS_ACT); S.Bt = (const bf16*)(F.ws + WS_W2); S.lda = DE; S.K = DE; S.npn = 4; S.NT = NT; S.nwg = NT * 4; S.G = F.G; S.c = F.bid; S.bexp = (size_t)1024 * 1024;
            S.tstart = (const LAS int*)(F.lds + L_TSTART); S.cnt = (const LAS int*)(F.lds + L_CNT); S.toklist = (const int*)(F.ws + WS_TOKLIST); S.gather = false; S.eb = 1; S.sA = 0x7D7D7D7D; S.sB = 0x79797979;
            pg8::EpiYs E{(unsigned char*)(F.ws + WS_YS), inptr(IN_EB2) + (size_t)l * NE * 1024};
            pg8::gemm_phase<pg8::EpiYs, pg8::MoeSched, false, true>(F.lds, F.tid, S, E);
        }
        SEAM(pb + 8);
        if (IN(pb + 9)) { { ENTER(); phase_combine(F, args, l); } if (l + 1 < DEPTH) { ENTER(); phase_weights(F, args, l + 1); } }
        SEAM(pb + 9);
    }
#undef IN
#undef SEAM
#undef ENTER
}

extern "C" void kernel_launch(void* const* d_in, const int* in_sizes, int n_in, void* d_out, int out_size, void* d_ws, size_t ws_size, hipStream_t stream) {
    static int grid = 0;
    if (grid == 0) {
        if (n_in != 30 || out_size != T * D || ws_size < WS_END) { fprintf(stderr, "kernel_launch: unexpected problem (n_in %d, out %d, ws %zu)\n", n_in, out_size, ws_size); grid = -1; return; }
        int dev = 0, cus = 0;
        if (hipGetDevice(&dev) != hipSuccess || hipDeviceGetAttribute(&cus, hipDeviceAttributeMultiprocessorCount, dev) != hipSuccess) { grid = -1; return; }
        if (hipFuncSetAttribute((const void*)fwd_kernel, hipFuncAttributeMaxDynamicSharedMemorySize, LDS_BYTES) != hipSuccess) { fprintf(stderr, "kernel_launch: hipFuncSetAttribute failed\n"); grid = -1; return; }
        int per_cu = 0;
        if (hipOccupancyMaxActiveBlocksPerMultiprocessor(&per_cu, (const void*)fwd_kernel, 512, LDS_BYTES) != hipSuccess || per_cu < 1) fprintf(stderr, "kernel_launch: occupancy query reports %d\n", per_cu);
        (void)hipGetLastError();
        grid = cus;
    }
    if (grid < 0) return;
    (void)hipMemsetAsync((char*)d_ws + WS_CTL, 0, CTL_ZERO_BYTES, stream);
    Args a{};
    for (int i = 0; i < 30; ++i) a.in[i] = (const float*)d_in[i];
    a.out = (float*)d_out; a.ws = (unsigned char*)d_ws; a.pad = 0;
#if MK_ONE_LAUNCH
    a.ph_lo = 0; a.ph_hi = N_PHASES; a.one_launch = 1;
    hipLaunchKernelGGL(fwd_kernel, dim3(grid), dim3(512), LDS_BYTES, stream, a);
#else
    for (int p = 0; p < N_PHASES; ++p) { a.ph_lo = p; a.ph_hi = p + 1; a.one_launch = 0; hipLaunchKernelGGL(fwd_kernel, dim3(grid), dim3(512), LDS_BYTES, stream, a); }
#endif
}
```

```cpp
#include <hip/hip_runtime.h>
#include <cstdio>
#include <cstdint>
#include <type_traits>

#ifndef MK_ONE_LAUNCH
#define MK_ONE_LAUNCH 1
#endif

#define LAS __attribute__((address_space(3)))
#define GAS __attribute__((address_space(1)))
typedef unsigned short bf16;
typedef short bf16x8 __attribute__((ext_vector_type(8)));
typedef short s16x4 __attribute__((ext_vector_type(4)));
typedef float f32x2 __attribute__((ext_vector_type(2)));
typedef float f32x4 __attribute__((ext_vector_type(4)));
typedef float f32x16 __attribute__((ext_vector_type(16)));
typedef unsigned u32x2 __attribute__((ext_vector_type(2)));
typedef unsigned u32x4 __attribute__((ext_vector_type(4)));
typedef __bf16 bf16x2_t __attribute__((ext_vector_type(2)));
typedef GAS unsigned gu32;
#define RLX_AGENT __ATOMIC_RELAXED, __HIP_MEMORY_SCOPE_AGENT
#define DI __device__ __forceinline__

constexpr int BATCH = 16, SEQ = 4096, T = BATCH * SEQ, D = 1024, DEPTH = 2;
constexpr int NQH = 16, NKVH = 4, HD = 64;
constexpr int IN_COLS = 6912, RWKV_COLS = 3328;
constexpr int C_Q = 0, C_K = 1024, C_V = 1280, C_R = 1536, C_RK = 2560, C_RV = 3584, C_WL = 4608, C_AL = 4672, C_GL = 4736, C_GA = 4864, C_GR = 5888;
constexpr int NE = 32, DE = 1024;
constexpr float LN_EPS = 1e-5f, GN_EPS = 64e-5f;
constexpr float ALPHA = 1.41421356237f;
constexpr int MAXTILES = 1056;

constexpr size_t MiB = 1u << 20;
constexpr size_t WS_CTL = 0, CTL_ZERO_BYTES = 1 * MiB;
constexpr size_t WS_ROPE = 1 * MiB;
constexpr size_t WS_WIN = 2 * MiB;
constexpr size_t WS_WAO = 16 * MiB, WS_WRO = 18 * MiB, WS_WOUT = 20 * MiB;
constexpr size_t WS_LORA = 22 * MiB;
constexpr size_t LO_W2 = 0, LO_A2 = 131072, LO_G2 = 262144, LO_V2 = 524288, LO_V1 = 589824;
constexpr size_t WS_W1 = 24 * MiB;
constexpr size_t WS_M8 = 88 * MiB;
constexpr size_t WS_W2 = 152 * MiB;
constexpr size_t WS_XB = 216 * MiB;
constexpr size_t WS_VF = 344 * MiB;
constexpr size_t WS_RWO = 472 * MiB;
constexpr size_t WS_M = 600 * MiB;
constexpr size_t WS_VL = 728 * MiB;
constexpr size_t WS_TOKINFO = 736 * MiB;
constexpr size_t WS_GATE = 737 * MiB;
constexpr size_t WS_TOKLIST = 738 * MiB;
constexpr size_t WS_STAT = 747 * MiB;
constexpr size_t WS_RIMG = 746 * MiB;
constexpr size_t WS_R = 752 * MiB;
constexpr size_t WS_ACT = WS_R, WS_YS = WS_R + 528 * MiB;
constexpr size_t WS_XB8 = WS_R + 1056 * MiB;
constexpr size_t WS_XI8 = WS_XB8 + 64 * MiB;
constexpr size_t WS_LI = WS_XI8 + 64 * MiB;
constexpr size_t WS_ATT8 = WS_LI + 32 * MiB;
constexpr size_t WS_END = WS_ATT8 + 64 * MiB;
static_assert((size_t)T * IN_COLS * 2 <= 864 * MiB && (size_t)MAXTILES * 256 * 1024 * 2 <= 528 * MiB, "region R");
constexpr int CW_TMO = 0;
constexpr int CW_BAR = 4096;
constexpr int CW_CNT = 16384;

constexpr int LDS_BYTES = 163840;
constexpr int LDSCTL_OFF = 155648;
constexpr int L_MISC = LDSCTL_OFF;
constexpr int L_BARST = LDS_BYTES - 64;
constexpr int L_CNT = LDSCTL_OFF + 256;
constexpr int L_BASE = LDSCTL_OFF + 384;
constexpr int L_TSTART = LDSCTL_OFF + 512;
constexpr int L_ASG = LDSCTL_OFF + 1024;
constexpr int L_LG = LDSCTL_OFF + 1024 + 4096;
static_assert(L_LG + 1024 <= L_BARST, "LDS map");

DI float bf2f(unsigned short b) { return __uint_as_float(((unsigned)b) << 16); }
DI unsigned f2bf(float f) { unsigned u = __float_as_uint(f); return (u + 0x7fffu + ((u >> 16) & 1u)) >> 16; }
DI unsigned pk2(float lo, float hi) { f32x2 v = {lo, hi}; bf16x2_t b = __builtin_convertvector(v, bf16x2_t); return __builtin_bit_cast(unsigned, b); }
DI unsigned pk4_fp8(float a, float b, float c, float d) { int w = 0; w = __builtin_amdgcn_cvt_pk_fp8_f32(a, b, w, false); w = __builtin_amdgcn_cvt_pk_fp8_f32(c, d, w, true); return (unsigned)w; }
DI unsigned short bf1(float x) { return (unsigned short)pk2(x, x); }
DI float bflo(unsigned w) { return __uint_as_float(w << 16); }
DI float bfhi(unsigned w) { return __uint_as_float(w & 0xffff0000u); }
#define DPP_ADD_(v, ctrl, rm) v += __builtin_bit_cast(float, __builtin_amdgcn_update_dpp(0, __builtin_bit_cast(int, v), ctrl, rm, 0xf, false))
DI float wave_sum(float v) {
    DPP_ADD_(v, 0x111, 0xf); DPP_ADD_(v, 0x112, 0xf); DPP_ADD_(v, 0x114, 0xf); DPP_ADD_(v, 0x118, 0xf); DPP_ADD_(v, 0x142, 0xa); DPP_ADD_(v, 0x143, 0xc);
    return __builtin_bit_cast(float, __builtin_amdgcn_readlane(__builtin_bit_cast(int, v), 63));
}
DI float tanh_fast(float x) { const float e = __expf(2.0f * x); return 1.0f - 2.0f * __builtin_amdgcn_rcpf(e + 1.0f); }
DI float shx(float v, int mask, int lane) { return __builtin_bit_cast(float, __builtin_amdgcn_ds_bpermute((lane ^ mask) << 2, __builtin_bit_cast(int, v))); }
DI float shl(float v, int src) { return __builtin_bit_cast(float, __builtin_amdgcn_ds_bpermute(src << 2, __builtin_bit_cast(int, v))); }
DI float sigmoidf_(float x) { return __builtin_amdgcn_rcpf(1.0f + __expf(-x)); }
DI f32x2 sigmoid2_l2(f32x2 xl) { f32x2 e = {__builtin_amdgcn_exp2f(xl[0]), __builtin_amdgcn_exp2f(xl[1])}; e = e + 1.0f; return (f32x2){__builtin_amdgcn_rcpf(e[0]), __builtin_amdgcn_rcpf(e[1])}; }

#define XB_TMO      128
#define XB_XCNT(j)  (256  + 64 * (j))
#define XB_XSUB(j)  (1280 + 64 * (j))
#define XB_XGEN(j)  (2304 + 64 * (j))
#define XB_TOP      3328
#define XB_TOPGEN   3392
#define XCD_BAR_WORDS 3456
#define XB_SPIN_CAP (1u << 18)
DI unsigned xb_ld(unsigned* p)              { return __hip_atomic_load(p, __ATOMIC_RELAXED, __HIP_MEMORY_SCOPE_AGENT); }
DI unsigned xb_add(unsigned* p, unsigned v) { return __hip_atomic_fetch_add(p, v, __ATOMIC_RELAXED, __HIP_MEMORY_SCOPE_AGENT); }
DI unsigned xb_xcc_id() { return (unsigned)__builtin_amdgcn_s_getreg((3 << 11) | 20) & 0xFu; }
#define XB_SPIN(cond, bar) do { unsigned _sp = 0; while (cond) { __builtin_amdgcn_s_sleep(1); \
    if ((++_sp & 255u) == 0u) { if (xb_ld(&(bar)[XB_TMO])) break; if (_sp > XB_SPIN_CAP) { atomicAdd(&(bar)[XB_TMO], 1u); break; } } } } while (0)
struct XcdBarrier { unsigned* bar; unsigned x; volatile LAS unsigned* st; };
DI bool xb_leader(int wave) { unsigned z_ = 0u; asm volatile("" : "+v"(z_)); return wave == 0 && __builtin_amdgcn_mbcnt_hi(~0u, __builtin_amdgcn_mbcnt_lo(~0u, z_)) == 0u; }
DI XcdBarrier xcd_barrier_post(unsigned* bar, volatile LAS unsigned* st, int wave) {
    XcdBarrier b; b.bar = bar; b.x = xb_xcc_id(); b.st = st;
    if (xb_leader(wave)) (void)xb_add(&bar[XB_XCNT(b.x)], 1u);
    return b;
}
DI void xcd_barrier_complete(unsigned* bar, unsigned x, unsigned& nloc, unsigned& nx) {
    const unsigned G = gridDim.x * gridDim.y * gridDim.z;
    unsigned sum, cnt, mine, sp = 0u;
    for (;;) {
        sum = 0u; cnt = 0u; mine = 0u;
#pragma unroll
        for (unsigned j = 0; j < 16; ++j) { const unsigned c = xb_ld(&bar[XB_XCNT(j)]); sum += c; cnt += (c > 0u) ? 1u : 0u; mine = (j == x) ? c : mine; }
        if (sum == G) break;
        __builtin_amdgcn_s_sleep(1);
        if ((++sp & 255u) == 0u) { if (xb_ld(&bar[XB_TMO])) break; if (sp > XB_SPIN_CAP) { atomicAdd(&bar[XB_TMO], 1u); break; } }
    }
    nloc = mine > 0u ? mine : 1u; nx = cnt > 0u ? cnt : 1u;
}
DI void xcd_barrier(const XcdBarrier& b, int wave) {
    asm volatile("s_waitcnt vmcnt(0)" ::: "memory");
    __syncthreads();
    if (xb_leader(wave)) {
        unsigned* bar = b.bar; asm volatile("" : "+s"(bar));
        __builtin_amdgcn_s_waitcnt(0);
        unsigned nloc = b.st[0], nx = b.st[1];
        if (nloc == 0u) { xcd_barrier_complete(bar, b.x, nloc, nx); b.st[0] = nloc; b.st[1] = nx; }
        const unsigned old = xb_add(&bar[XB_XSUB(b.x)], 1u);
        const unsigned gen = old / nloc;
        if (old + 1u == (gen + 1u) * nloc) {
            __builtin_amdgcn_fence(__ATOMIC_RELEASE, "agent");
            asm volatile("s_waitcnt vmcnt(0)" ::: "memory");
            const unsigned og = xb_add(&bar[XB_TOP], 1u);
            const unsigned tg = og / nx;
            if (og + 1u == (tg + 1u) * nx) xb_add(&bar[XB_TOPGEN], 1u);
            else XB_SPIN(xb_ld(&bar[XB_TOPGEN]) == tg, bar);
            __builtin_amdgcn_fence(__ATOMIC_ACQUIRE, "agent");
            xb_add(&bar[XB_XGEN(b.x)], 1u);
            asm volatile("s_waitcnt vmcnt(0)" ::: "memory");
        } else {
            XB_SPIN(xb_ld(&bar[XB_XGEN(b.x)]) == gen, bar);
            __builtin_amdgcn_fence(__ATOMIC_ACQUIRE, "agent");
            asm volatile("s_waitcnt vmcnt(0)" ::: "memory");
        }
    }
    __syncthreads();
}

namespace pg8 {
constexpr int BM = 256, BK = 64, HALF = 128, HTB = HALF * BK * 2, STAGE_BYTES = 8 * HTB, NXCD = 8, WGM = 8;
DI int lds_byte(int r, int c) { const int st = (r >> 4) * 2 + (c >> 5), rr = r & 15, cc = c & 31, ob = rr * 64 + cc * 2; return st * 1024 + (ob ^ (((ob >> 9) & 1) << 5)); }
DI void stage_rc(int b, int& R, int& C) { const int st = b / 1024, sb = b % 1024, swz = sb ^ (((sb >> 9) & 1) << 5); R = (st >> 1) * 16 + swz / 64; C = (st & 1) * 32 + (swz % 64) / 2; }
DI int perm32(int rho) { const int n = rho >> 4, i = rho & 15; return 8 * (i >> 2) + 4 * n + (i & 3); }

struct Unit { int pm, pn, e, r0; };

struct DenseSched {
    const bf16* A; const bf16* Bt; int lda, K; int nM, nN, nwg, G, c; int eb, sA, sB;
    DI void init(const bf16* A_, int lda_, const bf16* Bt_, int M, int N, int K_, int G_, int c_, int eb_ = 2, int sA_ = 0x7F7F7F7F, int sB_ = 0x7F7F7F7F) { A = A_; lda = lda_; Bt = Bt_; K = K_; nM = M / BM; nN = N / BM; nwg = nM * nN; G = G_; c = c_; eb = eb_; sA = sA_; sB = sB_; }
    DI bool next(int i, Unit& u) const {
        const long L = (long)i * G + c; if (L >= nwg) return false;
        int wgid = (int)L; { const int q = nwg / NXCD, r = nwg % NXCD, xcd = wgid % NXCD, off = wgid / NXCD; wgid = (xcd < r ? xcd * (q + 1) : r * (q + 1) + (xcd - r) * q) + off; }
        const int nig = WGM * nN, gid = wgid / nig, fm = gid * WGM, gsz = (nM - fm) < WGM ? (nM - fm) : WGM;
        u.pm = fm + ((wgid % nig) % gsz); u.pn = (wgid % nig) / gsz; u.e = 0; u.r0 = 0; return true;
    }
    DI const char* a_base(const Unit& u) const { return (const char*)A + (size_t)u.pm * BM * lda * eb; }
    DI const char* b_base(const Unit& u) const { return (const char*)Bt + (size_t)u.pn * BM * K * eb; }
    DI unsigned a_row_off(const Unit&, int r) const { return (unsigned)r * (unsigned)lda * (unsigned)eb; }
    DI int scale_a(const Unit&) const { return sA; }
};
struct DualSched {
    const bf16* A0; const bf16* A1; const bf16* B0; const bf16* B1; int lda, K; int nM, nN, nwg, G, c; int eb, sA, sA1, sB;
    DI void init(const void* A0_, int sA0_, const void* B0_, const void* A1_, int sA1_, const void* B1_, int lda_, int M, int N, int K_, int G_, int c_, int sB_) {
        A0 = (const bf16*)A0_; A1 = (const bf16*)A1_; B0 = (const bf16*)B0_; B1 = (const bf16*)B1_; lda = lda_; K = K_; nM = M / BM; nN = N / BM; nwg = nM * nN; G = G_; c = c_; eb = 1; sA = sA0_; sA1 = sA1_; sB = sB_; }
    DI bool next(int i, Unit& u) const {
        const long L = (long)(i >> 1) * G + c; if (L >= nwg) return false;
        int wgid = (int)L; { const int q = nwg / NXCD, r = nwg % NXCD, xcd = wgid % NXCD, off = wgid / NXCD; wgid = (xcd < r ? xcd * (q + 1) : r * (q + 1) + (xcd - r) * q) + off; }
        const int nig = WGM * nN, gid = wgid / nig, fm = gid * WGM, gsz = (nM - fm) < WGM ? (nM - fm) : WGM;
        u.pm = fm + ((wgid % nig) % gsz); u.pn = (wgid % nig) / gsz; u.e = i & 1; u.r0 = 0; return true;
    }
    DI const char* a_base(const Unit& u) const { return (const char*)(u.e ? A1 : A0) + (size_t)u.pm * BM * lda; }
    DI const char* b_base(const Unit& u) const { return (const char*)(u.e ? B1 : B0) + (size_t)u.pn * BM * K; }
    DI unsigned a_row_off(const Unit&, int r) const { return (unsigned)r * (unsigned)lda; }
    DI int scale_a(const Unit& u) const { return u.e ? sA1 : sA; }
};
struct MoeSched {
    const bf16* A; const bf16* Bt; int lda, K; int npn, NT, nwg, G, c; size_t bexp  ;
    const LAS int* tstart; const LAS int* cnt; const int* toklist; bool gather; int eb  ; int sA, sB  ;
    DI bool next(int i, Unit& u) const {
        const long L = (long)i * G + c; if (L >= nwg) return false;
        int wgid = (int)L; { const int q = nwg / NXCD, r = nwg % NXCD, xcd = wgid % NXCD, off = wgid / NXCD; wgid = (xcd < r ? xcd * (q + 1) : r * (q + 1) + (xcd - r) * q) + off; }
        wgid = __builtin_amdgcn_readfirstlane(wgid);
        const int rt = wgid / npn; u.pn = wgid % npn; u.pm = rt;
        unsigned z_ = 0u; asm volatile("" : "+v"(z_)); const int ln = (int)__builtin_amdgcn_mbcnt_hi(~0u, __builtin_amdgcn_mbcnt_lo(~0u, z_));
        const bool hit = (ln >= 1 && ln < NE) && (tstart[ln & 31] <= rt);
        const int e = __builtin_popcountll(__ballot(hit));
        u.e = e; u.r0 = (rt - tstart[e]) * BM; return true;
    }
    DI const char* a_base(const Unit& u) const { return gather ? (const char*)A : (const char*)A + (size_t)u.pm * BM * lda * eb; }
    DI const char* b_base(const Unit& u) const { return (const char*)Bt + (size_t)u.e * bexp + (size_t)u.pn * BM * K * eb; }
    DI unsigned a_row_off(const Unit& u, int r) const {
        if (!gather) return (unsigned)r * (unsigned)lda * (unsigned)eb;
        const int ce = cnt[u.e]; int idx = u.r0 + r; idx = idx < ce ? idx : u.r0;
        const int tok = toklist[(size_t)u.e * T + idx];
        return (unsigned)tok * (unsigned)lda * (unsigned)eb;
    }
    DI int scale_a(const Unit&) const { return sA; }
};

DI unsigned cvt_pk_bf16(float lo, float hi) { return pk2(lo, hi); }
typedef int v4i_ __attribute__((ext_vector_type(4)));
typedef int v8i_ __attribute__((ext_vector_type(8)));
DI v8i_ cat8(bf16x8 a, bf16x8 b) { return __builtin_shufflevector(__builtin_bit_cast(v4i_, a), __builtin_bit_cast(v4i_, b), 0, 1, 2, 3, 4, 5, 6, 7); }

template <class Epi, class Sched, bool GATHER, bool FP8 = false>
DI void gemm_phase(LAS unsigned char* lds, const int tid, const Sched& S, const Epi& E) {
    const int wid = __builtin_amdgcn_readfirstlane(tid >> 6), lane = tid & 63, wr = wid >> 2, wc = wid & 3, fr = lane & 15, fq = lane >> 4;
    const int K = S.K, EB = FP8 ? 1 : 2, nt = FP8 ? K / 128 : K / BK, lda = S.lda;
    unsigned voffB[2]; int Rr[2], Cc[2];
#pragma unroll
    for (int i = 0; i < 2; ++i) { int R, C; stage_rc(tid * 16 + i * 8192, R, C); const int Rb = Epi::PERM ? ((R & ~31) + perm32(R & 31)) : R;
        Rr[i] = R; Cc[i] = C; voffB[i] = (unsigned)(Rb * K * EB + C * 2); }
    const size_t kstep = (size_t)(BK * 2);
    int sclA = S.sA; const int sclB = S.sB;
    const size_t hstepB = (size_t)HALF * K * EB;
    const unsigned ldsw = (unsigned)wid * 1024u;
    const int aoff = lds_byte(wr * 64 + fr, fq * 8), boff = lds_byte(wc * 32 + fr, fq * 8);
#define PG8_SA(b, h) (((b) * 2 + (h)) * HTB)
#define PG8_SB(b, h) ((4 + (b) * 2 + (h)) * HTB)
#define PG8_STAGE_B(bufoff, gbase) do { _Pragma("unroll") for (int _i = 0; _i < 2; ++_i) \
        __builtin_amdgcn_global_load_lds((const unsigned*)((const char*)(gbase) + voffB[_i]), (LAS unsigned*)(lds + (bufoff) + ldsw + _i * 8192), 16, 0, 0); } while (0)
#define PG8_STAGE_A(bufoff, gbase, o0, o1) do { \
        __builtin_amdgcn_global_load_lds((const unsigned*)((const char*)(gbase) + (o0)), (LAS unsigned*)(lds + (bufoff) + ldsw), 16, 0, 0); \
        __builtin_amdgcn_global_load_lds((const unsigned*)((const char*)(gbase) + (o1)), (LAS unsigned*)(lds + (bufoff) + ldsw + 8192), 16, 0, 0); } while (0)
#define PG8_LDA(dst, b, h) do { _Pragma("unroll") for (int m = 0; m < 4; ++m) _Pragma("unroll") for (int k = 0; k < 2; ++k) dst[m][k] = *(const LAS bf16x8*)(lds + PG8_SA(b, h) + aoff + m * 2048 + k * 1024); } while (0)
#define PG8_LDB(dst, b, h) do { _Pragma("unroll") for (int n = 0; n < 2; ++n) _Pragma("unroll") for (int k = 0; k < 2; ++k) dst[n][k] = *(const LAS bf16x8*)(lds + PG8_SB(b, h) + boff + n * 2048 + k * 1024); } while (0)
#define PG8_MMA(ai, bj, At, Bt) do { __builtin_amdgcn_s_setprio(1); \
        if constexpr (FP8) { _Pragma("unroll") for (int m = 0; m < 4; ++m) _Pragma("unroll") for (int n = 0; n < 2; ++n) \
            asm volatile("v_mfma_scale_f32_16x16x128_f8f6f4 %0, %1, %2, %0, %3, %4 op_sel_hi:[0,0,0]" : "+v"(acc[ai][bj][m][n]) : "v"(cat8(Bt[n][0], Bt[n][1])), "v"(cat8(At[m][0], At[m][1])), "v"(sclB), "v"(sclA)); } \
        else { _Pragma("unroll") for (int m = 0; m < 4; ++m) _Pragma("unroll") for (int n = 0; n < 2; ++n) _Pragma("unroll") for (int k = 0; k < 2; ++k) \
            acc[ai][bj][m][n] = __builtin_amdgcn_mfma_f32_16x16x32_bf16(Bt[n][k], At[m][k], acc[ai][bj][m][n], 0, 0, 0); } \
        __builtin_amdgcn_s_setprio(0); } while (0)
#define PG8_WAIT_V(n) asm volatile("s_waitcnt vmcnt(" #n ")" ::: "memory")
#define PG8_WAIT_L(n) asm volatile("s_waitcnt lgkmcnt(" #n ")" ::: "memory")
#define PG8_BAR __builtin_amdgcn_s_barrier()
#define PG8_SCHED __builtin_amdgcn_sched_barrier(0)
    Unit cur, nxt; int ui = 0;
    if (!S.next(0, cur)) return;
    sclA = S.scale_a(cur);
    f32x4 acc[2][2][4][2];
#pragma unroll
    for (int a = 0; a < 2; ++a)
#pragma unroll
        for (int b = 0; b < 2; ++b)
#pragma unroll
            for (int m = 0; m < 4; ++m)
#pragma unroll
                for (int n = 0; n < 2; ++n) acc[a][b][m][n] = (f32x4){0.f, 0.f, 0.f, 0.f};
    bf16x8 At[4][2], B0[2][2], B1[2][2];
    unsigned avC[2][2], avN[2][2];
#pragma unroll
    for (int hh = 0; hh < 2; ++hh)
#pragma unroll
        for (int i = 0; i < 2; ++i) { avC[hh][i] = S.a_row_off(cur, hh * HALF + Rr[i]) + (unsigned)Cc[i] * 2u; avN[hh][i] = avC[hh][i]; }
    const char* cA = S.a_base(cur); const char* cB = S.b_base(cur);
    PG8_STAGE_B(PG8_SB(0, 0), cB); PG8_STAGE_B(PG8_SB(0, 1), cB + hstepB); PG8_STAGE_A(PG8_SA(0, 0), cA, avC[0][0], avC[0][1]); PG8_STAGE_A(PG8_SA(0, 1), cA, avC[1][0], avC[1][1]);
    if (wr == 1) PG8_BAR;
    PG8_WAIT_V(2); PG8_BAR;
    PG8_STAGE_B(PG8_SB(1, 0), cB + kstep); PG8_STAGE_A(PG8_SA(1, 0), cA + kstep, avC[0][0], avC[0][1]); PG8_STAGE_B(PG8_SB(1, 1), cB + hstepB + kstep);
    PG8_WAIT_V(6); PG8_BAR;
    for (;;) {
        const bool has_next = S.next(ui + 1, nxt);
        const char* nA = has_next ? S.a_base(nxt) : cA; const char* nB = has_next ? S.b_base(nxt) : cB;
        if (GATHER) {
#pragma unroll
            for (int hh = 0; hh < 2; ++hh)
#pragma unroll
                for (int i = 0; i < 2; ++i) avN[hh][i] = has_next ? (S.a_row_off(nxt, hh * HALF + Rr[i]) + (unsigned)Cc[i] * 2u) : avC[hh][i];
        }
        for (int t = 0; t < nt; t += 2) {
            const bool last = (t == nt - 2);
            const char* a1 = cA + (size_t)(t + 1) * kstep;
            const char* a2 = last ? nA : cA + (size_t)(t + 2) * kstep; const char* b2 = last ? nB : cB + (size_t)(t + 2) * kstep;
            const char* a3 = a2 + kstep; const char* b3 = b2 + kstep;
            unsigned x00 = avC[0][0], x01 = avC[0][1], x10 = avC[1][0], x11 = avC[1][1];
            if (GATHER) { x00 = last ? avN[0][0] : x00; x01 = last ? avN[0][1] : x01; x10 = last ? avN[1][0] : x10; x11 = last ? avN[1][1] : x11; }
            PG8_LDB(B0, 0, 0); PG8_LDB(B1, 0, 1); PG8_SCHED; PG8_LDA(At, 0, 0); PG8_STAGE_A(PG8_SA(1, 1), a1, avC[1][0], avC[1][1]);
            PG8_WAIT_V(8); PG8_WAIT_L(0); PG8_BAR; PG8_MMA(0, 0, At, B0); PG8_MMA(0, 1, At, B1); PG8_BAR; PG8_SCHED;
            PG8_LDA(At, 0, 1); PG8_STAGE_B(PG8_SB(0, 0), b2); PG8_STAGE_B(PG8_SB(0, 1), b2 + hstepB); PG8_STAGE_A(PG8_SA(0, 0), a2, x00, x01);
            PG8_WAIT_V(8); PG8_WAIT_L(0); PG8_BAR; PG8_MMA(1, 0, At, B0); PG8_MMA(1, 1, At, B1); PG8_BAR; PG8_SCHED;
            PG8_LDB(B0, 1, 0); PG8_LDB(B1, 1, 1); PG8_SCHED; PG8_LDA(At, 1, 0); PG8_STAGE_A(PG8_SA(0, 1), a2, x10, x11);
            PG8_WAIT_V(8); PG8_WAIT_L(0); PG8_BAR; PG8_MMA(0, 0, At, B0); PG8_MMA(0, 1, At, B1); PG8_BAR; PG8_SCHED;
            PG8_LDA(At, 1, 1); PG8_STAGE_B(PG8_SB(1, 0), b3); PG8_STAGE_B(PG8_SB(1, 1), b3 + hstepB); PG8_STAGE_A(PG8_SA(1, 0), a3, x00, x01);
            PG8_WAIT_V(8); PG8_WAIT_L(0); PG8_BAR; PG8_MMA(1, 0, At, B0); PG8_MMA(1, 1, At, B1); PG8_BAR; PG8_SCHED;
        }
        if (wr == 0) PG8_BAR;
        E(acc, cur, wr, wc, fr, fq);
        if (!has_next) break;
        if (!(Epi::CARRY && cur.e == 0)) {
#pragma unroll
            for (int a = 0; a < 2; ++a)
#pragma unroll
                for (int b = 0; b < 2; ++b)
#pragma unroll
                    for (int m = 0; m < 4; ++m)
#pragma unroll
                        for (int n = 0; n < 2; ++n) acc[a][b][m][n] = (f32x4){0.f, 0.f, 0.f, 0.f};
        }
        sclA = S.scale_a(nxt);
        cur = nxt; cA = nA; cB = nB; ++ui;
        if (GATHER) {
#pragma unroll
            for (int hh = 0; hh < 2; ++hh)
#pragma unroll
                for (int i = 0; i < 2; ++i) avC[hh][i] = avN[hh][i];
        }
        if (wr == 1) PG8_BAR;
    }
    PG8_WAIT_V(0);
    PG8_BAR;
#undef PG8_SA
#undef PG8_SB
#undef PG8_STAGE_A
#undef PG8_STAGE_B
#undef PG8_LDA
#undef PG8_LDB
#undef PG8_MMA
#undef PG8_WAIT_V
#undef PG8_WAIT_L
#undef PG8_BAR
#undef PG8_SCHED
}

struct EpiInProj {
    static constexpr bool PERM = true; static constexpr bool CARRY = false;
    bf16* P; const float* rope;
    DI void operator()(const f32x4 (&acc)[2][2][4][2], const Unit& u, int wr, int wc, int fr, int fq) const {
        const int row0 = u.pm * BM + wr * 64 + fr; const int colt = u.pn * BM; const int col0 = colt + wc * 32 + 8 * fq;
        const int kind = (u.pn < 5) ? 0 : ((u.pn < 19) ? 1 : 2);
        const float qs = (u.pn < 4) ? 0.125f : 1.0f;
        const int d0 = 16 * (wc & 1) + 4 * fq;
#pragma unroll
        for (int ai = 0; ai < 2; ++ai)
#pragma unroll
            for (int m = 0; m < 4; ++m) { const int row = row0 + ai * HALF + m * 16; bf16* rowp = P + (size_t)row * IN_COLS + col0;
                f32x4 cs = {1.f, 1.f, 1.f, 1.f}, sn = {0.f, 0.f, 0.f, 0.f};
                if (kind == 0) { const int pos = row & (SEQ - 1); cs = *(const GAS f32x4*)(rope + pos * 32 + d0); sn = *(const GAS f32x4*)(rope + SEQ * 32 + pos * 32 + d0); }
#pragma unroll
                for (int bj = 0; bj < 2; ++bj) { f32x4 v0 = acc[ai][bj][m][0], v1 = acc[ai][bj][m][1];
                    if (kind == 0) {
                        const f32x4 a0 = v0, a1 = v1;
                        v0[0] = (a0[0] * cs[0] - a0[1] * sn[0]) * qs; v0[1] = (a0[1] * cs[0] + a0[0] * sn[0]) * qs;
                        v0[2] = (a0[2] * cs[1] - a0[3] * sn[1]) * qs; v0[3] = (a0[3] * cs[1] + a0[2] * sn[1]) * qs;
                        v1[0] = (a1[0] * cs[2] - a1[1] * sn[2]) * qs; v1[1] = (a1[1] * cs[2] + a1[0] * sn[2]) * qs;
                        v1[2] = (a1[2] * cs[3] - a1[3] * sn[3]) * qs; v1[3] = (a1[3] * cs[3] + a1[2] * sn[3]) * qs;
                    } else if (kind == 2) {
                        f32x4 e0 = v0 * -1.44269504f, e1 = v1 * -1.44269504f;
#pragma unroll
                        for (int j = 0; j < 4; ++j) { e0[j] = __builtin_amdgcn_exp2f(e0[j]); e1[j] = __builtin_amdgcn_exp2f(e1[j]); }
                        e0 = e0 + 1.0f; e1 = e1 + 1.0f;
#pragma unroll
                        for (int j = 0; j < 4; ++j) { v0[j] = __builtin_amdgcn_rcpf(e0[j]); v1[j] = __builtin_amdgcn_rcpf(e1[j]); }
                    }
                    u32x4 w; w.x = cvt_pk_bf16(v0[0], v0[1]); w.y = cvt_pk_bf16(v0[2], v0[3]); w.z = cvt_pk_bf16(v1[0], v1[1]); w.w = cvt_pk_bf16(v1[2], v1[3]);
                    *(GAS u32x4*)(rowp + bj * HALF) = w; } }
    }
};
template <int MODE> struct EpiGate {
    static constexpr bool PERM = true; static constexpr bool CARRY = false;
    bf16* Mo; const bf16* Gp; unsigned char* M8;
    DI void operator()(const f32x4 (&acc)[2][2][4][2], const Unit& u, int wr, int wc, int fr, int fq) const {
        const int row0 = u.pm * BM + wr * 64 + fr; const int col0 = u.pn * BM + wc * 32 + 8 * fq;
#pragma unroll
        for (int ai = 0; ai < 2; ++ai)
#pragma unroll
            for (int m = 0; m < 4; ++m) { const int row = row0 + ai * HALF + m * 16;
#pragma unroll
                for (int bj = 0; bj < 2; ++bj) { const int col = col0 + bj * HALF;
                    const u32x4 g = *(const GAS u32x4*)(Gp + (size_t)row * IN_COLS + col);
                    f32x4 v0 = acc[ai][bj][m][0], v1 = acc[ai][bj][m][1];
                    v0[0] *= bflo(g.x); v0[1] *= bfhi(g.x); v0[2] *= bflo(g.y); v0[3] *= bfhi(g.y); v1[0] *= bflo(g.z); v1[1] *= bfhi(g.z); v1[2] *= bflo(g.w); v1[3] *= bfhi(g.w);
                    bf16* mp = Mo + (size_t)row * D + col;
                    if (MODE == 1) { const u32x4 o = *(const GAS u32x4*)mp;
                        v0[0] += bflo(o.x); v0[1] += bfhi(o.x); v0[2] += bflo(o.y); v0[3] += bfhi(o.y); v1[0] += bflo(o.z); v1[1] += bfhi(o.z); v1[2] += bflo(o.w); v1[3] += bfhi(o.w); }
                    if (MODE == 1) { v0 = v0 * 16.0f; v1 = v1 * 16.0f;
#pragma unroll
                        for (int j = 0; j < 4; ++j) { v0[j] = __builtin_amdgcn_fmed3f(v0[j], -448.0f, 448.0f); v1[j] = __builtin_amdgcn_fmed3f(v1[j], -448.0f, 448.0f); }
                        u32x2 w8; w8.x = pk4_fp8(v0[0], v0[1], v0[2], v0[3]); w8.y = pk4_fp8(v1[0], v1[1], v1[2], v1[3]);
                        *(GAS u32x2*)(M8 + (size_t)row * D + col) = w8; }
                    else { u32x4 w; w.x = cvt_pk_bf16(v0[0], v0[1]); w.y = cvt_pk_bf16(v0[2], v0[3]); w.z = cvt_pk_bf16(v1[0], v1[1]); w.w = cvt_pk_bf16(v1[2], v1[3]);
                    *(GAS u32x4*)mp = w; } } }
    }
};
struct EpiDual {
    static constexpr bool PERM = true; static constexpr bool CARRY = true;
    unsigned char* M8; const bf16* Ga; const bf16* Gr;
    DI void operator()(f32x4 (&acc)[2][2][4][2], const Unit& u, int wr, int wc, int fr, int fq) const {
        const int row0 = u.pm * BM + wr * 64 + fr; const int col0 = u.pn * BM + wc * 32 + 8 * fq;
#pragma unroll
        for (int ai = 0; ai < 2; ++ai)
#pragma unroll
            for (int m = 0; m < 4; ++m) { const int row = row0 + ai * HALF + m * 16;
#pragma unroll
                for (int bj = 0; bj < 2; ++bj) { const int col = col0 + bj * HALF;
                    const u32x4 g = *(const GAS u32x4*)(Gr + (size_t)row * IN_COLS + col);
                    f32x4 g0 = {bflo(g.x), bfhi(g.x), bflo(g.y), bfhi(g.y)}, g1 = {bflo(g.z), bfhi(g.z), bflo(g.w), bfhi(g.w)};
#pragma unroll
                    for (int j = 0; j < 4; ++j) { g0[j] = fmaxf(g0[j], 1e-30f); g1[j] = fmaxf(g1[j], 1e-30f); }
                    f32x4& v0 = acc[ai][bj][m][0]; f32x4& v1 = acc[ai][bj][m][1];
                    if (u.e == 0) {
                        const u32x4 a = *(const GAS u32x4*)(Ga + (size_t)row * IN_COLS + col);
                        const f32x4 a0 = {bflo(a.x), bfhi(a.x), bflo(a.y), bfhi(a.y)}, a1 = {bflo(a.z), bfhi(a.z), bflo(a.w), bfhi(a.w)};
#pragma unroll
                        for (int j = 0; j < 4; ++j) { v0[j] *= a0[j] * __builtin_amdgcn_rcpf(g0[j]); v1[j] *= a1[j] * __builtin_amdgcn_rcpf(g1[j]); }
                    } else {
                        f32x4 w0 = v0 * g0 * 16.0f, w1 = v1 * g1 * 16.0f;
#pragma unroll
                        for (int j = 0; j < 4; ++j) { w0[j] = __builtin_amdgcn_fmed3f(w0[j], -448.0f, 448.0f); w1[j] = __builtin_amdgcn_fmed3f(w1[j], -448.0f, 448.0f); }
                        u32x2 w8; w8.x = pk4_fp8(w0[0], w0[1], w0[2], w0[3]); w8.y = pk4_fp8(w1[0], w1[1], w1[2], w1[3]);
                        *(GAS u32x2*)(M8 + (size_t)row * D + col) = w8; } } }
    }
};
struct EpiResid {
    static constexpr bool PERM = true; static constexpr bool CARRY = false;
    bf16* XBp; const float* X32;
    DI void operator()(const f32x4 (&acc)[2][2][4][2], const Unit& u, int wr, int wc, int fr, int fq) const {
        const int row0 = u.pm * BM + wr * 64 + fr; const int col0 = u.pn * BM + wc * 32 + 8 * fq;
#pragma unroll
        for (int ai = 0; ai < 2; ++ai)
#pragma unroll
            for (int m = 0; m < 4; ++m) { bf16* rowp = XBp + (size_t)(row0 + ai * HALF + m * 16) * D + col0;
#pragma unroll
                for (int bj = 0; bj < 2; ++bj) {
                    f32x4 v0 = acc[ai][bj][m][0], v1 = acc[ai][bj][m][1];
                    if (X32) { const float* xp = X32 + (size_t)(row0 + ai * HALF + m * 16) * D + col0 + bj * HALF; v0 += ALPHA * *(const GAS f32x4*)xp; v1 += ALPHA * *(const GAS f32x4*)(xp + 4); }
                    else { const u32x4 o = *(const GAS u32x4*)(rowp + bj * HALF);
                    v0[0] += ALPHA * bflo(o.x); v0[1] += ALPHA * bfhi(o.x); v0[2] += ALPHA * bflo(o.y); v0[3] += ALPHA * bfhi(o.y);
                    v1[0] += ALPHA * bflo(o.z); v1[1] += ALPHA * bfhi(o.z); v1[2] += ALPHA * bflo(o.w); v1[3] += ALPHA * bfhi(o.w); }
                    u32x4 w; w.x = cvt_pk_bf16(v0[0], v0[1]); w.y = cvt_pk_bf16(v0[2], v0[3]); w.z = cvt_pk_bf16(v1[0], v1[1]); w.w = cvt_pk_bf16(v1[2], v1[3]);
                    *(GAS u32x4*)(rowp + bj * HALF) = w; } }
    }
};
struct EpiSwiglu {
    static constexpr bool PERM = true; static constexpr bool CARRY = false;
    bf16* ACT; const float* b1;
    DI void operator()(const f32x4 (&acc)[2][2][4][2], const Unit& u, int wr, int wc, int fr, int fq) const {
        const int row0 = u.pm * BM + wr * 64 + fr; const int col0 = u.pn * BM + wc * 32 + 8 * fq;
        f32x4 bv[2][2];
#pragma unroll
        for (int bj = 0; bj < 2; ++bj)
#pragma unroll
            for (int n = 0; n < 2; ++n) bv[bj][n] = *(const GAS f32x4*)(b1 + (size_t)u.e * 2048 + col0 + bj * HALF + 4 * n);
#pragma unroll
        for (int ai = 0; ai < 2; ++ai)
#pragma unroll
            for (int m = 0; m < 4; ++m) { const int row = row0 + ai * HALF + m * 16;
#pragma unroll
                for (int bj = 0; bj < 2; ++bj) { const f32x4 v0 = acc[ai][bj][m][0] + bv[bj][0], v1 = acc[ai][bj][m][1] + bv[bj][1];
                    float o[4];
#pragma unroll
                    for (int j = 0; j < 4; ++j) { const float g = (j < 2) ? v0[2 * j] : v1[2 * j - 4], li = (j < 2) ? v0[2 * j + 1] : v1[2 * j - 3];
                        const float xg = fminf(g, 7.0f), xl = __builtin_amdgcn_fmed3f(li, -7.0f, 7.0f);
                        const f32x2 t = __builtin_elementwise_fma((f32x2){xg, xl}, (f32x2){-1.702f * 1.44269504f, 4.0f}, (f32x2){0.0f, 4.0f});
                        o[j] = (xg * __builtin_amdgcn_rcpf(1.0f + __builtin_amdgcn_exp2f(t[0]))) * t[1]; }
                    *(GAS unsigned*)((unsigned char*)ACT + (size_t)row * DE + ((col0 + bj * HALF) >> 1)) = pk4_fp8(o[0], o[1], o[2], o[3]); } }
    }
};
struct EpiYs {
    static constexpr bool PERM = true; static constexpr bool CARRY = false;
    unsigned char* YS; const float* b2;
    DI void operator()(const f32x4 (&acc)[2][2][4][2], const Unit& u, int wr, int wc, int fr, int fq) const {
        const int row0 = u.pm * BM + wr * 64 + fr; const int col0 = u.pn * BM + wc * 32 + 8 * fq;
        f32x4 bv[2][2];
#pragma unroll
        for (int bj = 0; bj < 2; ++bj)
#pragma unroll
            for (int n = 0; n < 2; ++n) bv[bj][n] = *(const GAS f32x4*)(b2 + (size_t)u.e * 1024 + col0 + bj * HALF + 4 * n) * 16.0f;
#pragma unroll
        for (int ai = 0; ai < 2; ++ai)
#pragma unroll
            for (int m = 0; m < 4; ++m) { unsigned char* rowp = YS + (size_t)(row0 + ai * HALF + m * 16) * D + col0;
#pragma unroll
                for (int bj = 0; bj < 2; ++bj) { f32x4 v0 = acc[ai][bj][m][0] * 16.0f + bv[bj][0], v1 = acc[ai][bj][m][1] * 16.0f + bv[bj][1];
#pragma unroll
                    for (int j = 0; j < 4; ++j) { v0[j] = __builtin_amdgcn_fmed3f(v0[j], -448.0f, 448.0f); v1[j] = __builtin_amdgcn_fmed3f(v1[j], -448.0f, 448.0f); }
                    u32x2 w; w.x = pk4_fp8(v0[0], v0[1], v0[2], v0[3]); w.y = pk4_fp8(v1[0], v1[1], v1[2], v1[3]);
                    *(GAS u32x2*)(rowp + bj * HALF) = w; } }
    }
};
}

struct Args { const float* in[30]; float* out; unsigned char* ws; int ph_lo, ph_hi, one_launch, pad; };
struct Frame {
    LAS unsigned char* lds;
    int tid, lane, wave, G, bid;
    unsigned char* ws; float* out;
};
#define IN_X 0
#define IN_WIN 1
#define IN_SINKS 2
#define IN_WAO 3
#define IN_MU 4
#define IN_W0 5
#define IN_W2 6
#define IN_A0 7
#define IN_A2 8
#define IN_G2 9
#define IN_KK 10
#define IN_KA 11
#define IN_RK 12
#define IN_V0 13
#define IN_V1 14
#define IN_V2 15
#define IN_LNXW 16
#define IN_LNXB 17
#define IN_WRO 18
#define IN_WOUT 19
#define IN_LN1G 20
#define IN_LN1B 21
#define IN_ROUTW 22
#define IN_ROUTB 23
#define IN_EW1 24
#define IN_EB1 25
#define IN_EW2 26
#define IN_EB2 27
#define IN_LN2G 28
#define IN_LN2B 29


DI const float* inptr(int i) {
    const __attribute__((address_space(4))) char* kp = (const __attribute__((address_space(4))) char*)__builtin_amdgcn_kernarg_segment_ptr();
    asm volatile("" : "+s"(kp));
    const float* p = *(const float* const __attribute__((address_space(4)))*)(kp + 8 * i);
    return (const float*)(const GAS float*)p;
}

template <bool QKPERM>
DI void transpose_item(const float* W, int K, int N, bf16* WT, LAS float* scr, int item, int lane) {
    const int nblk = N / 32, kb = item / nblk, nb = item % nblk, k0 = 64 * kb, n0 = 32 * nb;
    int nsrc = n0 + (lane & 31);
    if (QKPERM && nsrc < 1280) { const int j = nsrc & 63; nsrc = (nsrc & ~63) + (j >> 1) + 32 * (j & 1); }
#pragma unroll 8
    for (int i = 0; i < 32; ++i) { const int kk = 2 * i + (lane >> 5); scr[kk * 33 + (lane & 31)] = W[(size_t)(k0 + kk) * N + nsrc]; }
    asm volatile("s_waitcnt lgkmcnt(0)" ::: "memory");
    const int c = lane & 7;
#pragma unroll
    for (int j = 0; j < 4; ++j) { const int n = (lane >> 3) + 8 * j; const LAS float* s = scr + (8 * c) * 33 + n;
        u32x4 o; o.x = pk2(s[0 * 33], s[1 * 33]); o.y = pk2(s[2 * 33], s[3 * 33]); o.z = pk2(s[4 * 33], s[5 * 33]); o.w = pk2(s[6 * 33], s[7 * 33]);
        *(GAS u32x4*)(WT + (size_t)(n0 + n) * K + k0 + 8 * c) = o; }
    asm volatile("s_waitcnt lgkmcnt(0)" ::: "memory");
}
template <bool QKPERM = false>
DI void transpose_item_fp8(const float* W, int K, int N, unsigned char* WT, LAS float* scr, int item, int lane, float scale) {
    const int nblk = N / 32, kb = item / nblk, nb = item % nblk, k0 = 64 * kb, n0 = 32 * nb;
    int nsrc = n0 + (lane & 31);
    if (QKPERM && nsrc < 1280) { const int j = nsrc & 63; nsrc = (nsrc & ~63) + (j >> 1) + 32 * (j & 1); }
#pragma unroll 8
    for (int i = 0; i < 32; ++i) { const int kk = 2 * i + (lane >> 5); scr[kk * 33 + (lane & 31)] = W[(size_t)(k0 + kk) * N + nsrc] * scale; }
    asm volatile("s_waitcnt lgkmcnt(0)" ::: "memory");
#pragma unroll
    for (int j = 0; j < 2; ++j) { const int id = lane + 64 * j, n = id >> 2, c = id & 3; const LAS float* q = scr + (16 * c) * 33 + n;
        u32x4 o; o.x = pk4_fp8(q[0 * 33], q[1 * 33], q[2 * 33], q[3 * 33]); o.y = pk4_fp8(q[4 * 33], q[5 * 33], q[6 * 33], q[7 * 33]);
        o.z = pk4_fp8(q[8 * 33], q[9 * 33], q[10 * 33], q[11 * 33]); o.w = pk4_fp8(q[12 * 33], q[13 * 33], q[14 * 33], q[15 * 33]);
        *(GAS u32x4*)(WT + (size_t)(n0 + n) * K + k0 + 16 * c) = o; }
    asm volatile("s_waitcnt lgkmcnt(0)" ::: "memory");
}
constexpr int CV_ITEMS = 32 * 64 * 32 + 32 * 64 * 16;
DI bool cv_in_scan(int G) { return G * 4 * 128 >= CV_ITEMS && G <= BATCH * 16; }
DI void phase_weights(Frame& F, const Args& a, int l) {
    LAS float* scr = (LAS float*)(F.lds + F.wave * 16384);
    const int gw = F.bid * 8 + F.wave, NGW = F.G * 8;
    unsigned char* ws = F.ws;
    constexpr int I_IN = 16 * (IN_COLS / 32), I_SQ = 16 * 32, I_W1 = 16 * 64, I_W2 = 16 * 32;
    const int NITEMS = I_IN + 3 * I_SQ + (cv_in_scan(F.G) ? 0 : 32 * I_W1 + 32 * I_W2);
    for (int it = gw; it < NITEMS; it += NGW) {
        int r = it;
        if (r < I_IN) { transpose_item_fp8<true>(inptr(IN_WIN) + (size_t)l * D * IN_COLS, D, IN_COLS, (unsigned char*)(ws + WS_WIN), scr, r, F.lane, 32.0f); continue; } r -= I_IN;
        if (r < I_SQ) { transpose_item_fp8<false>(inptr(IN_WAO) + (size_t)l * D * D, D, D, (unsigned char*)(ws + WS_WAO), scr, r, F.lane, 32.0f); continue; } r -= I_SQ;
        if (r < I_SQ) { transpose_item_fp8<false>(inptr(IN_WRO) + (size_t)l * D * D, D, D, (unsigned char*)(ws + WS_WRO), scr, r, F.lane, 32.0f); continue; } r -= I_SQ;
        if (r < I_SQ) { transpose_item_fp8<false>(inptr(IN_WOUT) + (size_t)l * D * D, D, D, (unsigned char*)(ws + WS_WOUT), scr, r, F.lane, 32.0f); continue; } r -= I_SQ;
        if (r < 32 * I_W1) { const int e = r / I_W1; transpose_item_fp8(inptr(IN_EW1) + ((size_t)l * NE + e) * D * 2048, D, 2048, (unsigned char*)(ws + WS_W1) + (size_t)e * 2048 * 1024, scr, r % I_W1, F.lane, 32.0f); continue; } r -= 32 * I_W1;
        { const int e = r / I_W2; transpose_item_fp8(inptr(IN_EW2) + ((size_t)l * NE + e) * DE * D, DE, D, (unsigned char*)(ws + WS_W2) + (size_t)e * 1024 * 1024, scr, r % I_W2, F.lane, 64.0f); }
    }
    {
        const float* rw = inptr(IN_ROUTW) + (size_t)l * D * NE; const float* g1 = inptr(IN_LN1G) + l * D; const float* b1 = inptr(IN_LN1B) + l * D;
        unsigned short* img = (unsigned short*)(ws + WS_RIMG);
        for (int idx = F.bid * 512 + F.tid; idx < D * NE; idx += F.G * 512) { const int d = idx >> 5, e = idx & 31; const float x = rw[idx] * g1[d]; const unsigned hi = f2bf(x); const unsigned lo = f2bf(x - bf2f((unsigned short)hi));
            img[e * D + d] = (unsigned short)hi; img[NE * D + e * D + d] = (unsigned short)lo; }
        if (gw < NE) { float cs = 0.f, ce = 0.f;
            for (int d = F.lane; d < D; d += 64) { const float wv = rw[d * NE + gw]; cs += wv * g1[d]; ce += wv * b1[d]; }
            cs = wave_sum(cs); ce = wave_sum(ce);
            if (F.lane == 0) { float* cse = (float*)(ws + WS_RIMG + 2 * NE * D * 2); cse[gw] = cs; cse[NE + gw] = ce + inptr(IN_ROUTB)[l * NE + gw]; } }
    }
    const int gt = F.bid * 512 + F.tid, NGT = F.G * 512;
    bf16* lo = (bf16*)(ws + WS_LORA);
    for (int i = gt; i < 1024 * 64; i += NGT) { const int c = i >> 6, m = i & 63;
        lo[LO_W2 / 2 + i] = (bf16)f2bf(inptr(IN_W2)[(size_t)l * 64 * 1024 + m * 1024 + c]);
        lo[LO_A2 / 2 + i] = (bf16)f2bf(inptr(IN_A2)[(size_t)l * 64 * 1024 + m * 1024 + c]); }
    for (int i = gt; i < 1024 * 128; i += NGT) { const int c = i >> 7, m = i & 127; lo[LO_G2 / 2 + i] = (bf16)f2bf(inptr(IN_G2)[(size_t)l * 128 * 1024 + m * 1024 + c]); }
    if (l > 0) {
        for (int i = gt; i < 1024 * 32; i += NGT) { const int c = i >> 5, m = i & 31; lo[LO_V2 / 2 + i] = (bf16)f2bf(inptr(IN_V2)[(size_t)(l - 1) * 32 * 1024 + m * 1024 + c]); }
        for (int i = gt; i < 32 * 1024; i += NGT) { const int m = i >> 10, d = i & 1023; lo[LO_V1 / 2 + i] = (bf16)f2bf(inptr(IN_V1)[(size_t)(l - 1) * 1024 * 32 + d * 32 + m]); }
    }
    if (l == 0) {
        const f32x4* xs = (const f32x4*)inptr(IN_X);
        unsigned* xi8 = (unsigned*)(ws + WS_XI8);
        for (size_t i = gt; i < (size_t)T * D / 4; i += NGT) { const f32x4 v = xs[i]; xi8[i] = pk4_fp8(v[0], v[1], v[2], v[3]); }
        float* rope = (float*)(ws + WS_ROPE);
        for (int i = gt; i < SEQ * 32; i += NGT) { const int pos = i >> 5, d = i & 31; const float inv = powf(10000.0f, -(float)(2 * d) / 64.0f); const float ang = (float)pos * inv;
            float sn, cs; sincosf(ang, &sn, &cs); rope[i] = cs; rope[SEQ * 32 + i] = sn; }
    }
}

DI int crow(int reg, int h) { return (reg & 3) + 8 * (reg >> 2) + 4 * h; }
#define MFMA32(a, b, c) __builtin_amdgcn_mfma_f32_32x32x16_bf16((a), (b), (c), 0, 0, 0)
DI void phase_attn(Frame& F, const Args& a, int l) {
    constexpr int KP = 144, VP = 192;
    LAS unsigned char* KL = F.lds; LAS unsigned char* VL = F.lds + 256 * KP;
    bf16* P = (bf16*)(F.ws + WS_R);
    const float* sinks = inptr(IN_SINKS) + l * NQH;
    const int lane = F.lane, r = lane & 31, h = lane >> 5, w = F.wave;
    const int i16 = lane & 15, tq = i16 >> 2, tp = i16 & 3, blk = (lane >> 4) & 1;
    auto kv_load = [&](int u, u32x4 (&kr)[4], u32x4 (&vr)[4]) { const int hk = u & 3, n = (u >> 2) & 31, b = u >> 7; const int row0 = b * SEQ + n * 128;
#pragma unroll
        for (int q = 0; q < 4; ++q) { const int idx = F.tid + 512 * q, j = idx >> 3, c8 = idx & 7; const int src = (n == 0 && j < 128) ? row0 + j : row0 - 128 + j;
            kr[q] = *(const GAS u32x4*)(P + (size_t)src * IN_COLS + C_K + 64 * hk + 8 * c8); vr[q] = *(const GAS u32x4*)(P + (size_t)src * IN_COLS + C_V + 64 * hk + 8 * c8); } };
    u32x4 kr[4], vr[4];
    if (F.bid < BATCH * 32 * NKVH) kv_load(F.bid, kr, vr);
    for (int u = F.bid; u < BATCH * 32 * NKVH; u += F.G) {
        const int hk = u & 3, n = (u >> 2) & 31, b = u >> 7;
        const int row0 = b * SEQ + n * 128;
        const int g = 4 * hk + (w >> 1);
        bf16x8 Bq2[2][4];
#pragma unroll
        for (int sb = 0; sb < 2; ++sb)
#pragma unroll
            for (int ks = 0; ks < 4; ++ks) Bq2[sb][ks] = *(const GAS bf16x8*)(P + (size_t)(row0 + 64 * (w & 1) + 32 * sb + r) * IN_COLS + C_Q + 64 * g + 16 * ks + 8 * h);
        __syncthreads();
#pragma unroll
        for (int q = 0; q < 4; ++q) { const int idx = F.tid + 512 * q, j = idx >> 3, c8 = idx & 7; *(LAS u32x4*)(KL + j * KP + 16 * c8) = kr[q]; *(LAS u32x4*)(VL + j * VP + 16 * c8) = vr[q]; }
        __syncthreads();
        if (u + F.G < BATCH * 32 * NKVH) kv_load(u + F.G, kr, vr);
        const float sink = sinks[g];
#pragma unroll 1
        for (int sb = 0; sb < 2; ++sb) {
            const int q0 = 64 * (w & 1) + 32 * sb;
            unsigned char* arow = F.ws + WS_ATT8 + (size_t)(row0 + q0 + r) * D + 64 * g;
            bf16x8 Bq[4];
#pragma unroll
            for (int ks = 0; ks < 4; ++ks) Bq[ks] = sb ? Bq2[1][ks] : Bq2[0][ks];
            f32x16 sc[5];
#pragma unroll
            for (int tt = 0; tt < 5; ++tt) { const int jb = q0 + 32 * tt;
#pragma unroll
                for (int i = 0; i < 16; ++i) sc[tt][i] = 0.f;
#pragma unroll
                for (int ks = 0; ks < 4; ++ks) { const bf16x8 ak = *(const LAS bf16x8*)(KL + (jb + r) * KP + (16 * ks + 8 * h) * 2); sc[tt] = MFMA32(ak, Bq[ks], sc[tt]); } }
            float mx = sink;
            if (n == 0) {
#pragma unroll
                for (int tt = 0; tt < 5; ++tt)
#pragma unroll
                    for (int i = 0; i < 16; ++i) sc[tt][i] = (q0 + 32 * tt + crow(i, h) >= 128) ? sc[tt][i] : -INFINITY;
            }
#pragma unroll
            for (int tt = 0; tt < 5; ++tt)
#pragma unroll
                for (int i = 0; i < 16; ++i) { const int c = crow(i, h);
                    if (tt == 0) sc[tt][i] = (c > r) ? sc[tt][i] : -INFINITY;
                    if (tt == 4) sc[tt][i] = (c <= r) ? sc[tt][i] : -INFINITY;
                    mx = fmaxf(mx, sc[tt][i]); }
            mx = fmaxf(mx, shx(mx, 32, lane));
            const float mxl = mx * 1.44269504f;
            f32x2 sum2 = {0.f, 0.f};
#pragma unroll
            for (int tt = 0; tt < 5; ++tt)
#pragma unroll
                for (int i = 0; i < 8; ++i) { f32x2 e = (f32x2){sc[tt][2 * i], sc[tt][2 * i + 1]} * 1.44269504f - mxl;
                    e[0] = __builtin_amdgcn_exp2f(e[0]); e[1] = __builtin_amdgcn_exp2f(e[1]); sc[tt][2 * i] = e[0]; sc[tt][2 * i + 1] = e[1]; sum2 = sum2 + e; }
            float sum = sum2[0] + sum2[1];
            sum += shx(sum, 32, lane);
            const float inv = 1.0f / (sum + __expf(sink - mx));
            f32x16 ot[2];
#pragma unroll
            for (int i = 0; i < 16; ++i) { ot[0][i] = 0.f; ot[1][i] = 0.f; }
#pragma unroll
            for (int tt = 0; tt < 5; ++tt)
#pragma unroll
                for (int s = 0; s < 2; ++s) {
                    u32x4 pw; pw.x = pk2(sc[tt][8 * s + 0], sc[tt][8 * s + 1]); pw.y = pk2(sc[tt][8 * s + 2], sc[tt][8 * s + 3]); pw.z = pk2(sc[tt][8 * s + 4], sc[tt][8 * s + 5]); pw.w = pk2(sc[tt][8 * s + 6], sc[tt][8 * s + 7]);
                    const bf16x8 Bp = __builtin_bit_cast(bf16x8, pw);
                    const int key0 = q0 + 32 * tt + 16 * s + 4 * h + tq;
#pragma unroll
                    for (int db = 0; db < 2; ++db) {
                        const LAS unsigned char* vp = VL + key0 * VP + (32 * db + 16 * blk) * 2 + 8 * tp;
                        const s16x4 lo = __builtin_bit_cast(s16x4, __builtin_amdgcn_ds_read_tr16_b64_v4i16((LAS s16x4*)vp));
                        const s16x4 hi = __builtin_bit_cast(s16x4, __builtin_amdgcn_ds_read_tr16_b64_v4i16((LAS s16x4*)(vp + 8 * VP)));
                        const bf16x8 Av = __builtin_shufflevector(lo, hi, 0, 1, 2, 3, 4, 5, 6, 7);
                        ot[db] = MFMA32(Av, Bp, ot[db]); } }
#pragma unroll
            for (int db = 0; db < 2; ++db)
#pragma unroll
                for (int gq = 0; gq < 4; ++gq) { const float i16 = inv * 16.0f;
                    *(GAS unsigned*)(arow + 32 * db + 8 * gq + 4 * h) = pk4_fp8(ot[db][4 * gq] * i16, ot[db][4 * gq + 1] * i16, ot[db][4 * gq + 2] * i16, ot[db][4 * gq + 3] * i16); }
        }
    }
    {
        const float* mu = inptr(IN_MU) + (size_t)l * RWKV_COLS + (C_WL - C_R);
        bf16* LI = (bf16*)(F.ws + WS_LI);
        for (size_t it = (size_t)F.bid * 512 + F.tid; it < (size_t)T * 32; it += (size_t)F.G * 512) { const int tok = (int)(it >> 5), cg = (int)(it & 31);
            const bf16* pc = P + (size_t)tok * IN_COLS + C_WL + 8 * cg;
            const u32x4 c4 = *(const GAS u32x4*)pc; u32x4 p4 = {0u, 0u, 0u, 0u}; if ((tok & (SEQ - 1)) != 0) p4 = *(const GAS u32x4*)(pc - IN_COLS);
            const f32x4 m0 = *(const GAS f32x4*)(mu + 8 * cg), m1 = *(const GAS f32x4*)(mu + 8 * cg + 4);
            float xs[8], ps[8];
            xs[0] = bflo(c4.x); xs[1] = bfhi(c4.x); xs[2] = bflo(c4.y); xs[3] = bfhi(c4.y); xs[4] = bflo(c4.z); xs[5] = bfhi(c4.z); xs[6] = bflo(c4.w); xs[7] = bfhi(c4.w);
            ps[0] = bflo(p4.x); ps[1] = bfhi(p4.x); ps[2] = bflo(p4.y); ps[3] = bfhi(p4.y); ps[4] = bflo(p4.z); ps[5] = bfhi(p4.z); ps[6] = bflo(p4.w); ps[7] = bfhi(p4.w);
#pragma unroll
            for (int j = 0; j < 8; ++j) { float x = xs[j] + (ps[j] - xs[j]) * (j < 4 ? m0[j] : m1[j - 4]); if (cg < 8) x = tanh_fast(x); else if (cg >= 16) x = sigmoidf_(x); xs[j] = x; }
            u32x4 o; o.x = pk2(xs[0], xs[1]); o.y = pk2(xs[2], xs[3]); o.z = pk2(xs[4], xs[5]); o.w = pk2(xs[6], xs[7]);
            *(GAS u32x4*)(LI + (size_t)tok * 256 + 8 * cg) = o; }
    }
    if (l > 0) {
        constexpr int RPB = 2064;
        LAS unsigned char* V1I = F.lds; LAS float* MUL = (LAS float*)(F.lds + 32 * RPB); LAS unsigned char* STG = F.lds + 32 * RPB + 4096 + w * 2112;
        const unsigned char* v1t = F.ws + WS_LORA + LO_V1;
        const float* mu = inptr(IN_MU) + (size_t)l * RWKV_COLS + (C_RV - C_R);
        bf16* VLo = (bf16*)(F.ws + WS_VL);
        __syncthreads();
        for (int i = F.tid; i < 32 * 128; i += 512) { const int row = i >> 7, c16 = i & 127; *(LAS u32x4*)(V1I + row * RPB + c16 * 16) = *(const GAS u32x4*)(v1t + (size_t)row * 2048 + c16 * 16); }
        if (F.tid < 256) *(LAS f32x4*)(MUL + 4 * F.tid) = *(const GAS f32x4*)(mu + 4 * F.tid);
        __syncthreads();
        for (int rbk = F.bid * 8 + w; rbk < T / 32; rbk += F.G * 8) {
            const int t0 = rbk * 32, s0 = lane >> 2; const bool zf = ((t0 & (SEQ - 1)) == 0) && (s0 == 0);
            const bf16* pa = P + (size_t)(t0 - 1 + s0 + (zf ? 1 : 0)) * IN_COLS + C_RV + 8 * (lane & 3);
            const bf16* pb = P + (size_t)(t0 + 15 + s0) * IN_COLS + C_RV + 8 * (lane & 3);
            const bf16* pc = P + (size_t)(t0 + 31) * IN_COLS + C_RV + 8 * (lane & 3);
            const u32x4 z4 = {0u, 0u, 0u, 0u};
            u32x4 c0 = *(const GAS u32x4*)pa, c1 = *(const GAS u32x4*)pb, c2 = z4; if (lane < 4) c2 = *(const GAS u32x4*)pc;
            f32x16 acc;
#pragma unroll
            for (int i = 0; i < 16; ++i) acc[i] = 0.f;
#pragma unroll 2
            for (int ch = 0; ch < 32; ++ch) {
                u32x4 n0 = c0, n1 = c1, n2 = c2;
                if (ch + 1 < 32) { n0 = *(const GAS u32x4*)(pa + 32 * (ch + 1)); n1 = *(const GAS u32x4*)(pb + 32 * (ch + 1)); if (lane < 4) n2 = *(const GAS u32x4*)(pc + 32 * (ch + 1)); }
                *(LAS u32x4*)(STG + lane * 16) = zf ? z4 : c0; *(LAS u32x4*)(STG + 1024 + lane * 16) = c1; if (lane < 4) *(LAS u32x4*)(STG + 2048 + lane * 16) = c2;
#pragma unroll
                for (int ks = 0; ks < 2; ++ks) { const int d = 32 * ch + 16 * ks + 8 * h;
                    const u32x4 c4 = *(const LAS u32x4*)(STG + (r + 1) * 64 + (2 * ks + h) * 16), p4 = *(const LAS u32x4*)(STG + r * 64 + (2 * ks + h) * 16);
                    const f32x4 m0 = *(const LAS f32x4*)(MUL + d), m1 = *(const LAS f32x4*)(MUL + d + 4);
                    float xs[8], ps[8];
                    xs[0] = bflo(c4.x); xs[1] = bfhi(c4.x); xs[2] = bflo(c4.y); xs[3] = bfhi(c4.y); xs[4] = bflo(c4.z); xs[5] = bfhi(c4.z); xs[6] = bflo(c4.w); xs[7] = bfhi(c4.w);
                    ps[0] = bflo(p4.x); ps[1] = bfhi(p4.x); ps[2] = bflo(p4.y); ps[3] = bfhi(p4.y); ps[4] = bflo(p4.z); ps[5] = bfhi(p4.z); ps[6] = bflo(p4.w); ps[7] = bfhi(p4.w);
#pragma unroll
                    for (int j = 0; j < 8; ++j) xs[j] = xs[j] + (ps[j] - xs[j]) * (j < 4 ? m0[j] : m1[j - 4]);
                    u32x4 aw; aw.x = pk2(xs[0], xs[1]); aw.y = pk2(xs[2], xs[3]); aw.z = pk2(xs[4], xs[5]); aw.w = pk2(xs[6], xs[7]);
                    const bf16x8 bv = *(const LAS bf16x8*)(V1I + r * RPB + d * 2);
                    acc = MFMA32(__builtin_bit_cast(bf16x8, aw), bv, acc); }
                asm volatile("s_waitcnt lgkmcnt(0)" ::: "memory");
                c0 = n0; c1 = n1; c2 = n2;
            }
#pragma unroll
            for (int i = 0; i < 16; ++i) VLo[(size_t)(t0 + crow(i, h)) * 32 + r] = (bf16)(pk2(acc[i], acc[i]) & 0xffffu);
        }
    }
}

DI bf16x8 frag_row(const LAS unsigned char* base, int pitch, int row, int kelem) { return *(const LAS bf16x8*)(base + row * pitch + kelem * 2); }
DI bf16x8 frag_row_perm(const LAS unsigned char* base, int pitch, int row, int k0, int h) {
    const s16x4 lo = *(const LAS s16x4*)(base + row * pitch + (k0 + 4 * h) * 2), hi = *(const LAS s16x4*)(base + row * pitch + (k0 + 8 + 4 * h) * 2);
    return __builtin_shufflevector(lo, hi, 0, 1, 2, 3, 4, 5, 6, 7); }
DI s16x4 tr4(const LAS unsigned char* p) { return __builtin_bit_cast(s16x4, __builtin_amdgcn_ds_read_tr16_b64_v4i16((LAS s16x4*)p)); }
DI bf16x8 frag_tr(const LAS unsigned char* base, int pitch, int k0, int col0, int lane) {
    const int h = lane >> 5, i16 = lane & 15, tq = i16 >> 2, tp = i16 & 3, blk = (lane >> 4) & 1;
    const LAS unsigned char* p = base + (k0 + 4 * h + tq) * pitch + (col0 + 16 * blk) * 2 + 8 * tp;
    const s16x4 lo = tr4(p), hi = tr4(p + 8 * pitch);
    return __builtin_shufflevector(lo, hi, 0, 1, 2, 3, 4, 5, 6, 7); }
DI f32x16 zero16() { f32x16 z;
#pragma unroll
    for (int i = 0; i < 16; ++i) z[i] = 0.f;
    return z; }
DI f32x16 acc_from_tr(const LAS unsigned char* base, int pitch, int row0, int col0, int lane) {
    const int h = lane >> 5, i16 = lane & 15, tq = i16 >> 2, tp = i16 & 3, blk = (lane >> 4) & 1;
    f32x16 o;
#pragma unroll
    for (int g = 0; g < 4; ++g) { const s16x4 q = tr4(base + (row0 + 8 * g + 4 * h + tq) * pitch + (col0 + 16 * blk) * 2 + 8 * tp);
#pragma unroll
        for (int e = 0; e < 4; ++e) o[4 * g + e] = bf2f((unsigned short)q[e]); }
    return o; }
DI void identity_frags(int r, int h, bf16x8 (&idf)[2]) {
#pragma unroll
    for (int ks = 0; ks < 2; ++ks) { const int e = r - 16 * ks - 8 * h;
#pragma unroll
        for (int j = 0; j < 8; ++j) idf[ks][j] = (e == j) ? (short)0x3F80 : (short)0; } }
DI f32x16 acc_by_mfma(const LAS unsigned char* base, int pitch, int row0, int col0, int r, int h, const bf16x8 (&idf)[2]) {
    f32x16 d = MFMA32(frag_row(base, pitch, row0 + r, col0 + 8 * h), idf[0], zero16());
    return MFMA32(frag_row(base, pitch, row0 + r, col0 + 16 + 8 * h), idf[1], d); }
DI bf16x8 packacc(const f32x16& x, int s) {
    u32x4 p; p.x = pk2(x[8 * s + 0], x[8 * s + 1]); p.y = pk2(x[8 * s + 2], x[8 * s + 3]); p.z = pk2(x[8 * s + 4], x[8 * s + 5]); p.w = pk2(x[8 * s + 6], x[8 * s + 7]);
    return __builtin_bit_cast(bf16x8, p); }

DI f32x16 gram(const LAS unsigned char* X, const LAS unsigned char* Y, int pitch, int r, int h) {
    f32x16 acc = zero16();
#pragma unroll
    for (int ks = 0; ks < 4; ++ks) acc = MFMA32(frag_row(X, pitch, r, 16 * ks + 8 * h), frag_row(Y, pitch, r, 16 * ks + 8 * h), acc);
    return acc; }
DI f32x16 mm_tt(const f32x16& X, const f32x16& Y, f32x16 acc) { const bf16x8 x0 = packacc(X, 0), x1 = packacc(X, 1), y0 = packacc(Y, 0), y1 = packacc(Y, 1); acc = MFMA32(x0, y0, acc); acc = MFMA32(x1, y1, acc); return acc; }

DI int lane_now() { unsigned z_ = 0u; asm volatile("" : "+v"(z_)); return (int)__builtin_amdgcn_mbcnt_hi(~0u, __builtin_amdgcn_mbcnt_lo(~0u, z_)); }
DI void bar_lds() { asm volatile("s_waitcnt lgkmcnt(0)" ::: "memory"); __builtin_amdgcn_s_barrier(); asm volatile("" ::: "memory"); }
DI float half_sum(float v, int h) {
    DPP_ADD_(v, 0xB1, 0xf); DPP_ADD_(v, 0x4E, 0xf); DPP_ADD_(v, 0x141, 0xf); DPP_ADD_(v, 0x140, 0xf);
    (void)h;
    return v + __builtin_bit_cast(float, __builtin_amdgcn_ds_swizzle(__builtin_bit_cast(int, v), 0x401F)); }
DI bf16x8 lora_afrag(const bf16* P, int tok, int col, const float* mu_rw, int act) {
    const u32x4 c4 = *(const GAS u32x4*)(P + (size_t)tok * IN_COLS + col); u32x4 p4 = {0u, 0u, 0u, 0u};
    if ((tok & (SEQ - 1)) != 0) p4 = *(const GAS u32x4*)(P + (size_t)(tok - 1) * IN_COLS + col);
    const f32x4 m0 = *(const GAS f32x4*)(mu_rw + col - C_R), m1 = *(const GAS f32x4*)(mu_rw + col - C_R + 4);
    float xs[8], ps[8];
    xs[0] = bflo(c4.x); xs[1] = bfhi(c4.x); xs[2] = bflo(c4.y); xs[3] = bfhi(c4.y); xs[4] = bflo(c4.z); xs[5] = bfhi(c4.z); xs[6] = bflo(c4.w); xs[7] = bfhi(c4.w);
    ps[0] = bflo(p4.x); ps[1] = bfhi(p4.x); ps[2] = bflo(p4.y); ps[3] = bfhi(p4.y); ps[4] = bflo(p4.z); ps[5] = bfhi(p4.z); ps[6] = bflo(p4.w); ps[7] = bfhi(p4.w);
#pragma unroll
    for (int j = 0; j < 8; ++j) { float x = xs[j] + (ps[j] - xs[j]) * (j < 4 ? m0[j] : m1[j - 4]); if (act == 1) x = tanh_fast(x); else if (act == 2) x = sigmoidf_(x); xs[j] = x; }
    u32x4 o; o.x = pk2(xs[0], xs[1]); o.y = pk2(xs[2], xs[3]); o.z = pk2(xs[4], xs[5]); o.w = pk2(xs[6], xs[7]);
    return __builtin_bit_cast(bf16x8, o); }
DI void load_shift16(const bf16* P, int t0, int colc, float muc, int h, float (&o)[16]) {
    unsigned short cu[16], pv[16];
#pragma unroll
    for (int i = 0; i < 16; ++i) { const int tok = t0 + crow(i, h); cu[i] = *(const GAS unsigned short*)(P + (size_t)tok * IN_COLS + colc); pv[i] = 0; if ((tok & (SEQ - 1)) != 0) pv[i] = *(const GAS unsigned short*)(P + (size_t)(tok - 1) * IN_COLS + colc); }
#pragma unroll
    for (int i = 0; i < 16; ++i) { const float c = bf2f(cu[i]), p = bf2f(pv[i]); o[i] = c + (p - c) * muc; } }

DI void phase_scan(Frame& F, const Args& a, int l) {
    constexpr int CH = 32, PB = 144, PQ = 136, NCHK = SEQ / CH, NP = NCHK + 6;
    constexpr int GSLOT = 4 * 32 * PB + 256;
    constexpr int PSLOT = 2 * 32 * PQ + 128;
    constexpr int QBUF = 96 * PQ;
    constexpr int OBUF = 32 * PQ;
    constexpr int SBUF = 9 * 1024;
    LAS unsigned char* GS = F.lds; LAS unsigned char* PS = GS + 2 * GSLOT; LAS unsigned char* QB = PS + 4 * PSLOT; LAS unsigned char* OB = QB + 2 * QBUF;
    LAS unsigned char* SBb = OB + 2 * OBUF;
    LAS float* CT = (LAS float*)(SBb + 4 * SBUF);
    constexpr int CVB = 4096;
    LAS unsigned char* CVb = (LAS unsigned char*)CT + 2304;
    static_assert(2 * GSLOT + 4 * PSLOT + 2 * QBUF + 2 * OBUF + 4 * SBUF + 2304 + 4 * CVB <= L_BARST, "scan LDS");
    const bf16* P = (const bf16*)(F.ws + WS_R);
    bf16* VF = (bf16*)(F.ws + WS_VF); unsigned char* RWO8 = F.ws + WS_RWO;
    const bf16* VLi = (const bf16*)(F.ws + WS_VL);
    const bf16* lora = (const bf16*)(F.ws + WS_LORA);
    const float* mu = inptr(IN_MU) + (size_t)l * RWKV_COLS;
    const int w = F.wave;
    for (int bh = F.bid; bh < BATCH * 16; bh += F.G) {
        const int b = bh >> 4, hd = bh & 15;
        __syncthreads();
        if (w == 0) { int ln0_ = lane_now(); const int cc = l * 1024 + 64 * hd + ln0_, cm = 64 * hd + ln0_;
            CT[ln0_] = inptr(IN_W0)[cc]; CT[64 + ln0_] = inptr(IN_A0)[cc]; CT[128 + ln0_] = (l > 0) ? inptr(IN_V0)[(l - 1) * 1024 + cm] : 0.f; CT[192 + ln0_] = inptr(IN_KK)[cc]; CT[256 + ln0_] = inptr(IN_KA)[cc];
            CT[320 + ln0_] = inptr(IN_RK)[cc]; CT[384 + ln0_] = mu[cm]; CT[448 + ln0_] = mu[1024 + cm]; CT[512 + ln0_] = mu[2048 + cm]; }
        __syncthreads();
        auto post_tokens = [&](int cp, int tlo, int lane, float lnw, float lnb) {
            const LAS unsigned char* ps = PS + (cp & 3) * PSLOT; const LAS unsigned char* cV = ps; const LAS unsigned char* cG = ps + 32 * PQ; const LAS float* RK = (const LAS float*)(ps + 64 * PQ);
            const LAS unsigned char* ob = OB + (cp & 1) * OBUF;
            const int tg = b * SEQ + cp * CH;
            f32x16 D1 = zero16(), D2 = zero16();
            { const int r = lane & 31, h = lane >> 5; const bf16x8 ones = {0x3F80, 0x3F80, 0x3F80, 0x3F80, 0x3F80, 0x3F80, 0x3F80, 0x3F80};
#pragma unroll
              for (int ks = 0; ks < 4; ++ks) { const LAS unsigned char* fp = ob + (tlo + (r & 7)) * PQ + (16 * ks + 8 * h) * 2;
                  const s16x4 flo = *(const LAS s16x4*)fp, fhi = *(const LAS s16x4*)(fp + 8); const bf16x8 f = __builtin_shufflevector(flo, fhi, 0, 1, 2, 3, 4, 5, 6, 7); D1 = MFMA32(f, ones, D1); D2 = MFMA32(f, f, D2); } }
            float R[4], NB[4];
#pragma unroll
            for (int i = 0; i < 4; ++i) { const float m = D1[i] * (1.0f / 64.0f); const float var = fmaxf(D2[i] * (1.0f / 64.0f) - m * m, 0.f); R[i] = __builtin_amdgcn_rsqf(var + GN_EPS); NB[i] = -m * R[i]; }
            const f32x2 lnw2 = {lnw, lnw}, lnb2 = {lnb, lnb};
#pragma unroll
            for (int j = 0; j < 8; j += 2) { const int t = tlo + j; const int src0 = j + 32 * ((j >> 2) & 1);
                const float r0 = R[j & 3], r1 = R[(j + 1) & 3], n0 = NB[j & 3], n1 = NB[(j + 1) & 3];
                const f32x2 rs = {__builtin_bit_cast(float, __builtin_amdgcn_readlane(__builtin_bit_cast(int, r0), src0)), __builtin_bit_cast(float, __builtin_amdgcn_readlane(__builtin_bit_cast(int, r1), src0 + 1))};
                const f32x2 nb = {__builtin_bit_cast(float, __builtin_amdgcn_readlane(__builtin_bit_cast(int, n0), src0)), __builtin_bit_cast(float, __builtin_amdgcn_readlane(__builtin_bit_cast(int, n1), src0 + 1))};
                const f32x2 o = {bf2f(*(const LAS unsigned short*)(ob + t * PQ + 2 * lane)), bf2f(*(const LAS unsigned short*)(ob + (t + 1) * PQ + 2 * lane))};
                const f32x2 vv = {bf2f(*(const LAS unsigned short*)(cV + t * PQ + 2 * lane)), bf2f(*(const LAS unsigned short*)(cV + (t + 1) * PQ + 2 * lane))};
                const f32x2 gg = {bf2f(*(const LAS unsigned short*)(cG + t * PQ + 2 * lane)), bf2f(*(const LAS unsigned short*)(cG + (t + 1) * PQ + 2 * lane))};
                const f32x2 rk2 = {RK[t], RK[t + 1]};
                const f32x2 A = rs * lnw2, B = nb * lnw2 + lnb2;
                f32x2 x = o * A + B; x = rk2 * vv + x; x = x * gg;
                x = x * 4.0f; x[0] = __builtin_amdgcn_fmed3f(x[0], -448.0f, 448.0f); x[1] = __builtin_amdgcn_fmed3f(x[1], -448.0f, 448.0f);
                const unsigned pk = pk4_fp8(x[0], x[0], x[1], x[1]);
                *(GAS unsigned char*)(RWO8 + (size_t)(tg + t) * 1024 + 64 * hd + lane) = (unsigned char)(pk & 0xffu);
                *(GAS unsigned char*)(RWO8 + (size_t)(tg + t + 1) * 1024 + 64 * hd + lane) = (unsigned char)((pk >> 16) & 0xffu); } };
        if (w >= 4) {
            const int pw = w - 4;
            LAS unsigned char* sb = SBb + pw * SBUF;
            int ln0_ = lane_now();
            auto dma = [&](int c, const bf16* bA, int pA, int cA, const bf16* bB, int pB, int cB, bool bnoshift, int ln) {
                int cc_ = c; asm volatile("" : "+s"(cc_));
                const int t0 = b * SEQ + cc_ * CH; const int tt0 = ln >> 4, pc = ln & 15; const bool isB = pc >= 8;
                const bf16* base = isB ? bB : bA; const int pitch = isB ? pB : pA; const int col = isB ? (cB + 8 * (pc - 8)) : (cA + 8 * pc);
                const int row0 = (isB && bnoshift) ? (t0 + tt0) : (t0 - 1 + tt0);
                const bf16* s0 = base + (size_t)row0 * pitch + col; const size_t rstep = (size_t)4 * pitch;
#pragma unroll
                for (int k = 0; k < 8; ++k) __builtin_amdgcn_global_load_lds((const unsigned*)(s0 + k * rstep), (LAS unsigned*)(sb + k * 1024), 16, 0, 0);
                const bf16* s8 = base + (size_t)(t0 + 31) * pitch + col;
                __builtin_amdgcn_global_load_lds((const unsigned*)s8, (LAS unsigned*)(sb + 8 * 1024), 16, 0, 0); };
            const bf16* LI = (const bf16*)(F.ws + WS_LI);
            const bool cv_on = cv_in_scan(F.G) && (bh == F.bid);
            const int cv_wid = F.bid * 4 + pw, cv_nw = F.G * 4;
            LAS unsigned char* cvb = CVb + pw * CVB;
            auto cv_issue = [&](int j, int ln) {
                const int it = j * cv_nw + cv_wid;
                if (cv_on && it < CV_ITEMS) {
                    const bool is1 = it < 65536; const int r_ = is1 ? it : it - 65536;
                    const int e = is1 ? (r_ >> 11) : (r_ >> 10), rem = is1 ? (r_ & 2047) : (r_ & 1023), kb = is1 ? (rem >> 5) : (rem >> 4), nb = is1 ? (rem & 31) : (rem & 15), N = is1 ? 2048 : 1024;
                    const float* s0 = (is1 ? inptr(IN_EW1) : inptr(IN_EW2)) + ((size_t)(l * NE + e) * 1024 + kb * 16 + (ln >> 4)) * N + nb * 64 + 4 * (ln & 15);
#pragma unroll
                    for (int k = 0; k < 4; ++k) __builtin_amdgcn_global_load_lds((const unsigned*)(s0 + (size_t)(4 * k) * N), (LAS unsigned*)(cvb + k * 1024), 16, 0, 0);
                } };
            auto cv_step = [&](int j, int ln) {
                const int it = j * cv_nw + cv_wid;
                if (cv_on && it < CV_ITEMS) {
                    const bool is1 = it < 65536; const int r_ = is1 ? it : it - 65536;
                    const int e = is1 ? (r_ >> 11) : (r_ >> 10), rem = is1 ? (r_ & 2047) : (r_ & 1023), kb = is1 ? (rem >> 5) : (rem >> 4), nb = is1 ? (rem & 31) : (rem & 15), N = is1 ? 2048 : 1024;
                    unsigned char* dst = F.ws + (is1 ? WS_W1 : WS_W2) + ((size_t)e * N + nb * 64 + ln) * 1024 + kb * 16;
                    const float sc = is1 ? 32.0f : 64.0f;
                    f32x2 v[8];
#pragma unroll
                    for (int kk = 0; kk < 8; ++kk) v[kk] = (f32x2){*(const LAS float*)(cvb + (2 * kk) * 256 + ln * 4), *(const LAS float*)(cvb + (2 * kk + 1) * 256 + ln * 4)} * sc;
                    u32x4 o; o.x = pk4_fp8(v[0][0], v[0][1], v[1][0], v[1][1]); o.y = pk4_fp8(v[2][0], v[2][1], v[3][0], v[3][1]); o.z = pk4_fp8(v[4][0], v[4][1], v[5][0], v[5][1]); o.w = pk4_fp8(v[6][0], v[6][1], v[7][0], v[7][1]);
                    *(GAS u32x4*)dst = o;
                    asm volatile("s_waitcnt lgkmcnt(0)" ::: "memory");
                    __builtin_amdgcn_sched_barrier(0);
                }
                cv_issue(j + 1, ln); };
            auto clear_prev = [&](bool first, int ln, int byte_lo) { if (first) { unsigned z_ = 0u; asm volatile("" : "+v"(z_)); if (ln < 8) *(LAS u32x4*)(sb + byte_lo + ln * 16) = (u32x4){z_, z_, z_, z_}; asm volatile("s_waitcnt lgkmcnt(0)" ::: "memory"); } };
            auto afrag_sb = [&](int r, int cb) -> bf16x8 { return *(const LAS bf16x8*)(sb + (r + 1) * 256 + cb); };
            auto shift16 = [&](int cb, float muc, int h, float (&o)[16]) {
#pragma unroll
                for (int i = 0; i < 16; i += 2) { const int t = crow(i, h);
                    const float x0 = bf2f(*(const LAS unsigned short*)(sb + t * 256 + cb)), x1 = bf2f(*(const LAS unsigned short*)(sb + (t + 1) * 256 + cb)), x2 = bf2f(*(const LAS unsigned short*)(sb + (t + 2) * 256 + cb));
                    const f32x2 cu = {x1, x2}, pv = {x0, x1}; const f32x2 q = cu + (pv - cu) * muc; o[i] = q[0]; o[i + 1] = q[1]; } };
            bf16x8 Bq[16];
            auto bload = [&](size_t lo_off, int km, int nks, int r, int h, int nb_lo = 0, int nb_hi = 2) {
#pragma unroll
                for (int nb = 0; nb < 2; ++nb) if (nb >= nb_lo && nb < nb_hi)
#pragma unroll
                    for (int ks = 0; ks < 8; ++ks) if (ks < nks) Bq[nb * nks + ks] = *(const GAS bf16x8*)(lora + lo_off / 2 + (size_t)(64 * hd + 32 * nb + r) * km + 16 * ks + 8 * h); };
            { int ln = lane_now(); dma(pw, LI, 256, 64, P, IN_COLS, C_RK + 64 * hd, false, ln); cv_issue(0, ln); bload(LO_A2, 64, 4, ln & 31, ln >> 5); }
            for (int i = 0; i < pw; ++i) bar_lds();
            for (int c = pw; c < NCHK; c += 4) {
                const int t0 = b * SEQ + c * CH; const bool first = (c == 0);
                LAS unsigned char* gs = GS + (c & 1) * GSLOT; LAS unsigned char* cAt = gs; LAS unsigned char* cRt = gs + 32 * PB; LAS unsigned char* cBt = gs + 64 * PB; LAS unsigned char* cKt = gs + 96 * PB; LAS float* GC = (LAS float*)(gs + 128 * PB);
                LAS unsigned char* ps = PS + (c & 3) * PSLOT; LAS unsigned char* cV = ps; LAS unsigned char* cG = ps + 32 * PQ; LAS float* RK = (LAS float*)(ps + 64 * PQ);
                int r, h, ln;
                { ln = lane_now(); r = ln & 31; h = ln >> 5; }
                unsigned apk[2][8], bpk[2][8], kpk[2][8];
                asm volatile("s_waitcnt vmcnt(0)" ::: "memory");
                cv_step(4 * (c >> 2) + 0, ln);
                clear_prev(first, ln, 128);
                {
                    f32x16 acc0 = zero16(), acc1 = zero16();
#pragma unroll
                    for (int ks = 0; ks < 4; ++ks) { const bf16x8 af = afrag_sb(r, (16 * ks + 8 * h) * 2); acc0 = MFMA32(af, Bq[ks], acc0); acc1 = MFMA32(af, Bq[4 + ks], acc1); }
                    float ksv[2][16], ss[16];
                    shift16(128 + 2 * r, CT[448 + r], h, ksv[0]); shift16(128 + 2 * (32 + r), CT[480 + r], h, ksv[1]);
                    const float kkc[2] = {CT[192 + r], CT[224 + r]}, kac[2] = {CT[256 + r], CT[288 + r]}, a0c[2] = {CT[64 + r], CT[96 + r]};
#pragma unroll
                    for (int i = 0; i < 16; ++i) asm volatile("" : "+v"(ksv[0][i]), "+v"(ksv[1][i]));
                    asm volatile("s_waitcnt lgkmcnt(0)" ::: "memory");
                    __builtin_amdgcn_sched_barrier(0);
                    dma(c, LI, 256, 0, P, IN_COLS, C_R + 64 * hd, false, ln);
#pragma unroll
                    for (int i = 0; i < 16; ++i) asm volatile("" : "+v"(acc0[i]), "+v"(acc1[i]));
                    bload(LO_W2, 64, 4, r, h);
                    __builtin_amdgcn_sched_barrier(0);
                    unsigned alp[2][8];
#pragma unroll
                    for (int i = 0; i < 8; ++i) { const float b0 = -1.44269504f * a0c[0], b1 = -1.44269504f * a0c[1];
                        const f32x2 s0 = sigmoid2_l2((f32x2){acc0[2 * i], acc0[2 * i + 1]} * -1.44269504f + b0), s1 = sigmoid2_l2((f32x2){acc1[2 * i], acc1[2 * i + 1]} * -1.44269504f + b1);
                        alp[0][i] = pk2(s0[0], s0[1]); alp[1][i] = pk2(s1[0], s1[1]); asm volatile("" : "+v"(alp[0][i]), "+v"(alp[1][i])); }
#pragma unroll
                    for (int i = 0; i < 16; i += 2) { const f32x2 ka = (f32x2){ksv[0][i], ksv[0][i + 1]} * kkc[0], kb = (f32x2){ksv[1][i], ksv[1][i + 1]} * kkc[1]; const f32x2 q = ka * ka + kb * kb; ss[i] = q[0]; ss[i + 1] = q[1]; }
#pragma unroll
                    for (int i = 0; i < 16; ++i) ss[i] = fminf(__builtin_amdgcn_rsqf(half_sum(ss[i], h)), 1e12f);
#pragma unroll
                    for (int nb = 0; nb < 2; ++nb)
#pragma unroll
                        for (int i = 0; i < 8; ++i) { const f32x2 k = {ksv[nb][2 * i], ksv[nb][2 * i + 1]}, av = {bflo(alp[nb][i]), bfhi(alp[nb][i])}, sp = {ss[2 * i], ss[2 * i + 1]};
                            const f32x2 n = (k * kkc[nb]) * sp, bn = n * av, kf = k * (av * kac[nb] + (1.0f - kac[nb]));
                            apk[nb][i] = pk2(-n[0], -n[1]); bpk[nb][i] = pk2(bn[0], bn[1]); kpk[nb][i] = pk2(kf[0], kf[1]);
                            asm volatile("" : "+v"(apk[nb][i]), "+v"(bpk[nb][i]), "+v"(kpk[nb][i])); }
                }
                bar_lds();
                { ln = lane_now(); r = ln & 31; h = ln >> 5; }
                float rk[16]; unsigned atp[2][8], rtp[2][8], btp[2][8], ktp[2][8], gcp;
                asm volatile("s_waitcnt vmcnt(0)" ::: "memory");
                cv_step(4 * (c >> 2) + 1, ln);
                clear_prev(first, ln, 128);
                {
                    f32x16 acc0 = zero16(), acc1 = zero16();
#pragma unroll
                    for (int ks = 0; ks < 4; ++ks) { const bf16x8 af = afrag_sb(r, (16 * ks + 8 * h) * 2); acc0 = MFMA32(af, Bq[ks], acc0); acc1 = MFMA32(af, Bq[4 + ks], acc1); }
                    float rsv[2][16];
                    shift16(128 + 2 * r, CT[384 + r], h, rsv[0]); shift16(128 + 2 * (32 + r), CT[416 + r], h, rsv[1]);
#pragma unroll
                    for (int i = 0; i < 16; ++i) asm volatile("" : "+v"(rsv[0][i]), "+v"(rsv[1][i]));
                    asm volatile("s_waitcnt lgkmcnt(0)" ::: "memory");
                    __builtin_amdgcn_sched_barrier(0);
                    dma(c, LI, 256, 128, LI, 256, 192, false, ln);
                    __builtin_amdgcn_sched_barrier(0);
                    float gcv[2];
#pragma unroll
                    for (int nb = 0; nb < 2; ++nb) { const float w0c_ = CT[32 * nb + r], rkc_ = CT[320 + 32 * nb + r];
                        float wd[16];
#pragma unroll
                        for (int i = 0; i < 16; i += 2) { const float bw = -1.44269504f * w0c_;
                            const f32x2 sg = sigmoid2_l2((nb ? (f32x2){acc1[i], acc1[i + 1]} : (f32x2){acc0[i], acc0[i + 1]}) * -1.44269504f + bw) * (-0.60653066f * 1.44269504f);
                            wd[i] = __builtin_amdgcn_exp2f(sg[0]); wd[i + 1] = __builtin_amdgcn_exp2f(sg[1]); }
                        float sp4[4], so4[4];
#pragma unroll
                        for (int g = 0; g < 4; ++g) { sp4[g] = (wd[4 * g] * wd[4 * g + 1]) * (wd[4 * g + 2] * wd[4 * g + 3]); so4[g] = shx(sp4[g], 32, ln); }
                        float run = 1.0f, gex[16];
#pragma unroll
                        for (int g = 0; g < 4; ++g) { const float p0 = h ? so4[g] : sp4[g], p1 = h ? sp4[g] : so4[g]; float x = h ? run * p0 : run; run = run * p0 * p1;
#pragma unroll
                            for (int e = 0; e < 4; ++e) { gex[4 * g + e] = x; x *= wd[4 * g + e]; } }
                        gcv[nb] = run;
#pragma unroll
                        for (int i = 0; i < 8; ++i) { const f32x2 gx = {gex[2 * i], gex[2 * i + 1]}; const f32x2 g = gx * (f32x2){wd[2 * i], wd[2 * i + 1]}; const f32x2 iv = {__builtin_amdgcn_rcpf(g[0]), __builtin_amdgcn_rcpf(g[1])};
                            const f32x2 kp = {bflo(kpk[nb][i]), bfhi(kpk[nb][i])}, rv = {rsv[nb][2 * i], rsv[nb][2 * i + 1]};
                            const f32x2 q = (rv * kp) * rkc_;
                            const f32x2 rkn = nb ? (f32x2){rk[2 * i], rk[2 * i + 1]} + q : q; rk[2 * i] = rkn[0]; rk[2 * i + 1] = rkn[1];
                            const f32x2 at = (f32x2){bflo(apk[nb][i]), bfhi(apk[nb][i])} * gx, rt = rv * g, bt = (f32x2){bflo(bpk[nb][i]), bfhi(bpk[nb][i])} * iv, kt = kp * iv;
                            atp[nb][i] = pk2(at[0], at[1]); rtp[nb][i] = pk2(rt[0], rt[1]); btp[nb][i] = pk2(bt[0], bt[1]); ktp[nb][i] = pk2(kt[0], kt[1]);
                            asm volatile("" : "+v"(atp[nb][i]), "+v"(rtp[nb][i]), "+v"(btp[nb][i]), "+v"(ktp[nb][i])); }
                        __builtin_amdgcn_sched_barrier(0); }
                    gcp = pk2(gcv[0], gcv[1]); asm volatile("" : "+v"(gcp));
#pragma unroll
                    for (int i = 0; i < 16; ++i) asm volatile("" : "+v"(rk[i]));
                }
                bar_lds();
                { ln = lane_now(); r = ln & 31; h = ln >> 5; }
                unsigned gpk[2][8];
                bload(LO_G2, 128, 8, r, h);
                asm volatile("s_waitcnt vmcnt(0)" ::: "memory");
                cv_step(4 * (c >> 2) + 2, ln);
                {
                    f32x16 acc0 = zero16(), acc1 = zero16();
#pragma unroll
                    for (int ks = 0; ks < 8; ++ks) { const bf16x8 af = afrag_sb(r, (16 * ks + 8 * h) * 2); acc0 = MFMA32(af, Bq[ks], acc0); acc1 = MFMA32(af, Bq[8 + ks], acc1); }
                    asm volatile("s_waitcnt lgkmcnt(0)" ::: "memory");
                    __builtin_amdgcn_sched_barrier(0);
                    dma(c, P, IN_COLS, C_RV + 64 * hd, (l > 0) ? (const bf16*)VF : P, (l > 0) ? 1024 : IN_COLS, (l > 0) ? 64 * hd : C_RV + 64 * hd, l > 0, ln);
#pragma unroll
                    for (int i = 0; i < 8; ++i) { gpk[0][i] = pk2(acc0[2 * i], acc0[2 * i + 1]); gpk[1][i] = pk2(acc1[2 * i], acc1[2 * i + 1]); asm volatile("" : "+v"(gpk[0][i]), "+v"(gpk[1][i])); }
                    if (l > 0) bload(LO_V2, 32, 2, r, h);
                    __builtin_amdgcn_sched_barrier(0);
#pragma unroll
                    for (int i = 0; i < 16; ++i) { rk[i] = half_sum(rk[i], h); asm volatile("" : "+v"(rk[i])); }
                }
                bar_lds();
                { ln = lane_now(); r = ln & 31; h = ln >> 5; }
                bf16x8 avf[2] = {(bf16x8){0, 0, 0, 0, 0, 0, 0, 0}, (bf16x8){0, 0, 0, 0, 0, 0, 0, 0}};
                if (l > 0) { avf[0] = *(const GAS bf16x8*)(VLi + (size_t)(t0 + r) * 32 + 8 * h); avf[1] = *(const GAS bf16x8*)(VLi + (size_t)(t0 + r) * 32 + 16 + 8 * h); }
                asm volatile("s_waitcnt vmcnt(0)" ::: "memory");
                cv_step(4 * (c >> 2) + 3, ln);
                clear_prev(first, ln, 0);
                {
                    asm volatile("" : "+v"(avf[0]), "+v"(avf[1]));
                    f32x16 av0 = zero16(), av1 = zero16();
                    if (l > 0) { av0 = MFMA32(avf[0], Bq[0], av0); av0 = MFMA32(avf[1], Bq[1], av0); av1 = MFMA32(avf[0], Bq[2], av1); av1 = MFMA32(avf[1], Bq[3], av1); }
                    float vs[2][16]; unsigned vfp[2][8];
#pragma unroll
                    for (int nb = 0; nb < 2; ++nb) { const int cb = 2 * (32 * nb + r); shift16(cb, CT[512 + 32 * nb + r], h, vs[nb]);
#pragma unroll
                        for (int i = 0; i < 8; ++i) { vfp[nb][i] = 0u; if (l > 0) vfp[nb][i] = (unsigned)*(const LAS unsigned short*)(sb + crow(2 * i, h) * 256 + 128 + cb) | ((unsigned)*(const LAS unsigned short*)(sb + crow(2 * i + 1, h) * 256 + 128 + cb) << 16); } }
#pragma unroll
                    for (int i = 0; i < 16; ++i) asm volatile("" : "+v"(vs[0][i]), "+v"(vs[1][i]));
#pragma unroll
                    for (int i = 0; i < 8; ++i) asm volatile("" : "+v"(vfp[0][i]), "+v"(vfp[1][i]));
                    asm volatile("s_waitcnt lgkmcnt(0)" ::: "memory");
                    __builtin_amdgcn_sched_barrier(0);
                    if (c + 4 < NCHK) dma(c + 4, LI, 256, 64, P, IN_COLS, C_RK + 64 * hd, false, ln);
#pragma unroll
                    for (int i = 0; i < 16; ++i) asm volatile("" : "+v"(av0[i]), "+v"(av1[i]));
                    __builtin_amdgcn_sched_barrier(0);
#pragma unroll
                    for (int nb = 0; nb < 2; ++nb) { const int cb = 2 * (32 * nb + r); const float v0c_ = CT[128 + 32 * nb + r];
                        if (l == 0) {
#pragma unroll
                            for (int i = 0; i < 16; ++i) *(GAS unsigned short*)(VF + (size_t)(t0 + crow(i, h)) * 1024 + 64 * hd + 32 * nb + r) = (unsigned short)(pk2(vs[nb][i], vs[nb][i]) & 0xffffu);
                        } else {
#pragma unroll
                            for (int i = 0; i < 16; ++i) { const float vf = (i & 1) ? bfhi(vfp[nb][i >> 1]) : bflo(vfp[nb][i >> 1]); vs[nb][i] = vs[nb][i] + (vf - vs[nb][i]) * sigmoidf_(v0c_ + (nb ? av1[i] : av0[i])); }
                        }
#pragma unroll
                        for (int i = 0; i < 8; ++i) { const int ta = crow(2 * i, h), tb = crow(2 * i + 1, h); const unsigned vp = pk2(vs[nb][2 * i], vs[nb][2 * i + 1]);
                            *(LAS unsigned short*)(cV + ta * PQ + cb) = (unsigned short)(vp & 0xffffu); *(LAS unsigned short*)(cV + tb * PQ + cb) = (unsigned short)(vp >> 16);
                            *(LAS unsigned short*)(cG + ta * PQ + cb) = (unsigned short)(gpk[nb][i] & 0xffffu); *(LAS unsigned short*)(cG + tb * PQ + cb) = (unsigned short)(gpk[nb][i] >> 16);
                            *(LAS unsigned short*)(cAt + ta * PB + cb) = (unsigned short)(atp[nb][i] & 0xffffu); *(LAS unsigned short*)(cAt + tb * PB + cb) = (unsigned short)(atp[nb][i] >> 16);
                            *(LAS unsigned short*)(cRt + ta * PB + cb) = (unsigned short)(rtp[nb][i] & 0xffffu); *(LAS unsigned short*)(cRt + tb * PB + cb) = (unsigned short)(rtp[nb][i] >> 16);
                            *(LAS unsigned short*)(cBt + ta * PB + cb) = (unsigned short)(btp[nb][i] & 0xffffu); *(LAS unsigned short*)(cBt + tb * PB + cb) = (unsigned short)(btp[nb][i] >> 16);
                            *(LAS unsigned short*)(cKt + ta * PB + cb) = (unsigned short)(ktp[nb][i] & 0xffffu); *(LAS unsigned short*)(cKt + tb * PB + cb) = (unsigned short)(ktp[nb][i] >> 16); }
                        if (h == 0) GC[32 * nb + r] = nb ? bfhi(gcp) : bflo(gcp); }
                    if (r == 0) {
#pragma unroll
                        for (int i = 0; i < 16; ++i) RK[crow(i, h)] = rk[i];
                    }
                }
                if (c + 4 < NCHK) bload(LO_A2, 64, 4, r, h);
                bar_lds();
            }
            for (int i = pw + 4 * (NCHK / 4); i < NP; ++i) bar_lds();
        } else if (w >= 2) {
            const int ib = w - 2;
            float lnw, lnb; { const int ln0_ = lane_now(); lnw = inptr(IN_LNXW)[l * 1024 + 64 * hd + ln0_]; lnb = inptr(IN_LNXB)[l * 1024 + 64 * hd + ln0_]; }
            f32x16 ST0 = zero16(), ST1 = zero16(), VUo = zero16(), WT0 = zero16(), WT1 = zero16();
            bf16x8 idf[2]; { const int ln0_ = lane_now(); identity_frags(ln0_ & 31, ln0_ >> 5, idf); }
            auto s_period = [&](int p, auto ALL_) { constexpr bool ALL = decltype(ALL_)::value;
                int ln = lane_now();
                const int lane = ln, r = ln & 31, h = ln >> 5;
                const int cs = p - 5, cl = p - 4;
                if (ALL || (cs >= 0 && cs < NCHK)) {
                    LAS unsigned char* cQo = QB + (cs & 1) * QBUF; LAS unsigned char* cQs = cQo + 32 * PQ; LAS unsigned char* ob = OB + (cs & 1) * OBUF;
                    const bf16x8 s00 = packacc(ST0, 0), s01 = packacc(ST0, 1), s10 = packacc(ST1, 0), s11 = packacc(ST1, 1);
                    f32x16 O = VUo;
                    O = MFMA32(frag_row_perm(cQo, PQ, r, 0, h), s00, O); O = MFMA32(frag_row_perm(cQo, PQ, r, 16, h), s01, O);
                    O = MFMA32(frag_row_perm(cQo, PQ, r, 32, h), s10, O); O = MFMA32(frag_row_perm(cQo, PQ, r, 48, h), s11, O);
                    f32x16 n0 = WT0, n1 = WT1;
                    n0 = MFMA32(frag_row_perm(cQs, PQ, r, 0, h), s00, n0); n0 = MFMA32(frag_row_perm(cQs, PQ, r, 16, h), s01, n0);
                    n0 = MFMA32(frag_row_perm(cQs, PQ, r, 32, h), s10, n0); n0 = MFMA32(frag_row_perm(cQs, PQ, r, 48, h), s11, n0);
                    n1 = MFMA32(frag_row_perm(cQs, PQ, 32 + r, 0, h), s00, n1); n1 = MFMA32(frag_row_perm(cQs, PQ, 32 + r, 16, h), s01, n1);
                    n1 = MFMA32(frag_row_perm(cQs, PQ, 32 + r, 32, h), s10, n1); n1 = MFMA32(frag_row_perm(cQs, PQ, 32 + r, 48, h), s11, n1);
                    ST0 = n0; ST1 = n1;
#pragma unroll
                    for (int i = 0; i < 16; i += 2) { const unsigned pk = pk2(O[i], O[i + 1]);
                        *(LAS unsigned short*)(ob + crow(i, h) * PQ + 2 * (32 * ib + r)) = (unsigned short)(pk & 0xffffu); *(LAS unsigned short*)(ob + crow(i + 1, h) * PQ + 2 * (32 * ib + r)) = (unsigned short)(pk >> 16); }
                }
                if (ALL || (cl >= 0 && cl < NCHK)) {
                    LAS unsigned char* gs = GS + (cl & 1) * GSLOT; LAS unsigned char* cAt = gs; LAS unsigned char* cRt = gs + 32 * PB; LAS unsigned char* cBt = gs + 64 * PB; LAS unsigned char* cKt = gs + 96 * PB; LAS float* GC = (LAS float*)(gs + 128 * PB);
                    LAS unsigned char* cV = PS + (cl & 3) * PSLOT;
                    f32x16 N = gram(cBt, cAt, PB, r, h), L = gram(cAt, cBt, PB, r, h), Mbr = gram(cBt, cRt, PB, r, h), Mkr = gram(cKt, cRt, PB, r, h), Y = gram(cAt, cKt, PB, r, h);
#pragma unroll
                    for (int i = 0; i < 16; ++i) { const int rw = crow(i, h); N[i] = (rw < r) ? N[i] : 0.f; L[i] = (rw > r) ? L[i] : 0.f; Mbr[i] = (rw <= r) ? Mbr[i] : 0.f; Mkr[i] = (rw <= r) ? Mkr[i] : 0.f; Y[i] = (rw > r) ? Y[i] : 0.f; }
#pragma unroll
                    for (int st = 0; st < 5; ++st) { Y = mm_tt(N, Y, Y); if (st < 4) { const f32x16 Nn = mm_tt(L, N, zero16()), Ln = mm_tt(N, L, zero16()); N = Nn; L = Ln; } }
                    const f32x16 Uo = mm_tt(Y, Mbr, Mkr);
                    const bf16x8 y0 = packacc(Y, 0), y1 = packacc(Y, 1);
                    f32x16 Us0 = acc_by_mfma(cKt, PB, 0, 0, r, h, idf), Us1 = acc_by_mfma(cKt, PB, 0, 32, r, h, idf);
                    Us0 = MFMA32(y0, frag_tr(cBt, PB, 0, 0, lane), Us0); Us0 = MFMA32(y1, frag_tr(cBt, PB, 16, 0, lane), Us0);
                    Us1 = MFMA32(y0, frag_tr(cBt, PB, 0, 32, lane), Us1); Us1 = MFMA32(y1, frag_tr(cBt, PB, 16, 32, lane), Us1);
                    const float g0 = GC[r], g1 = GC[32 + r];
#pragma unroll
                    for (int i = 0; i < 16; ++i) { Us0[i] *= g0; Us1[i] *= g1; }
                    const bf16x8 v0f = frag_tr(cV, PQ, 0, 32 * ib, lane), v1f = frag_tr(cV, PQ, 16, 32 * ib, lane);
                    VUo = MFMA32(packacc(Uo, 0), v0f, zero16()); VUo = MFMA32(packacc(Uo, 1), v1f, VUo);
                    WT0 = MFMA32(packacc(Us0, 0), v0f, zero16()); WT0 = MFMA32(packacc(Us0, 1), v1f, WT0);
                    WT1 = MFMA32(packacc(Us1, 0), v0f, zero16()); WT1 = MFMA32(packacc(Us1, 1), v1f, WT1);
                }
                { const int cp = p - 6; if (ALL || (cp >= 0 && cp < NCHK)) post_tokens(cp, 16 + 8 * ib, lane, lnw, lnb); }
                bar_lds();
            };
            for (int p = 0; p < NP; ++p) { if (p >= 6 && p < NCHK + 4) s_period(p, std::true_type{}); else s_period(p, std::false_type{}); }
        } else {
            const int jb = w;
            int ln0_ = lane_now();
            const float lnw = inptr(IN_LNXW)[l * 1024 + 64 * hd + ln0_], lnb = inptr(IN_LNXB)[l * 1024 + 64 * hd + ln0_];
            bf16x8 idf[2]; identity_frags(ln0_ & 31, ln0_ >> 5, idf);
            auto y_period = [&](int p, auto ALL_) { constexpr bool ALL = decltype(ALL_)::value;
                int ln = lane_now();
                const int lane = ln, r = ln & 31, h = ln >> 5;
                const int cl = p - 4, cp = p - 6;
                if (ALL || (cl >= 0 && cl < NCHK)) {
                    LAS unsigned char* gs = GS + (cl & 1) * GSLOT; LAS unsigned char* cAt = gs; LAS unsigned char* cRt = gs + 32 * PB; LAS unsigned char* cBt = gs + 64 * PB; LAS float* GC = (LAS float*)(gs + 128 * PB);
                    LAS unsigned char* cQo = QB + (cl & 1) * QBUF; LAS unsigned char* cQs = cQo + 32 * PQ;
                    f32x16 N = gram(cBt, cAt, PB, r, h), L = gram(cAt, cBt, PB, r, h), Mbr = gram(cBt, cRt, PB, r, h);
#pragma unroll
                    for (int i = 0; i < 16; ++i) { const int rw = crow(i, h); N[i] = (rw < r) ? N[i] : 0.f; L[i] = (rw > r) ? L[i] : 0.f; Mbr[i] = (rw <= r) ? Mbr[i] : 0.f; }
                    f32x16 Y = acc_from_tr(cAt, PB, 0, 32 * jb, lane);
#pragma unroll
                    for (int st = 0; st < 5; ++st) { Y = mm_tt(N, Y, Y); if (st < 4) { const f32x16 Nn = mm_tt(L, N, zero16()), Ln = mm_tt(N, L, zero16()); N = Nn; L = Ln; } }
                    f32x16 Q = acc_by_mfma(cRt, PB, 0, 32 * jb, r, h, idf); Q = mm_tt(Mbr, Y, Q);
#pragma unroll
                    for (int i = 0; i < 16; i += 2) { const unsigned pk = pk2(Q[i], Q[i + 1]);
                        *(LAS unsigned short*)(cQo + crow(i, h) * PQ + 2 * (32 * jb + r)) = (unsigned short)(pk & 0xffffu); *(LAS unsigned short*)(cQo + crow(i + 1, h) * PQ + 2 * (32 * jb + r)) = (unsigned short)(pk >> 16); }
                    const bf16x8 y0 = packacc(Y, 0), y1 = packacc(Y, 1);
#pragma unroll
                    for (int j2 = 0; j2 < 2; ++j2) { f32x16 q2;
#pragma unroll
                        for (int i = 0; i < 16; ++i) q2[i] = (j2 == jb && crow(i, h) == r) ? 1.0f : 0.f;
                        q2 = MFMA32(frag_tr(cBt, PB, 0, 32 * j2, lane), y0, q2); q2 = MFMA32(frag_tr(cBt, PB, 16, 32 * j2, lane), y1, q2);
#pragma unroll
                        for (int i = 0; i < 16; i += 2) { const f32x2 q = (f32x2){q2[i], q2[i + 1]} * (f32x2){GC[32 * j2 + crow(i, h)], GC[32 * j2 + crow(i + 1, h)]}; const unsigned pk = pk2(q[0], q[1]);
                            *(LAS unsigned short*)(cQs + (32 * j2 + crow(i, h)) * PQ + 2 * (32 * jb + r)) = (unsigned short)(pk & 0xffffu); *(LAS unsigned short*)(cQs + (32 * j2 + crow(i + 1, h)) * PQ + 2 * (32 * jb + r)) = (unsigned short)(pk >> 16); } }
                }
                if (ALL || (cp >= 0 && cp < NCHK)) post_tokens(cp, 8 * jb, lane, lnw, lnb);
                bar_lds();
            };
            for (int p = 0; p < NP; ++p) { if (p >= 6 && p < NCHK + 4) y_period(p, std::true_type{}); else y_period(p, std::false_type{}); }
        }
    }
}

#define DPP_MAXU_(v, ctrl, rm) { const unsigned t_ = (unsigned)__builtin_amdgcn_update_dpp(0, (int)(v), ctrl, rm, 0xf, false); v = v > t_ ? v : t_; }
DI unsigned half_maxu(unsigned v, int h) {
    DPP_MAXU_(v, 0x111, 0xf); DPP_MAXU_(v, 0x112, 0xf); DPP_MAXU_(v, 0x114, 0xf); DPP_MAXU_(v, 0x118, 0xf); DPP_MAXU_(v, 0x142, 0xa);
    const unsigned s31 = (unsigned)__builtin_amdgcn_readlane((int)v, 31), s63 = (unsigned)__builtin_amdgcn_readlane((int)v, 63);
    return h ? s63 : s31; }
DI void phase_router(Frame& F, const Args& a, int l) {
    constexpr int RPB = 2064;
    LAS unsigned char* RWH = F.lds; LAS unsigned char* RWL = F.lds + 32 * RPB; LAS float* CS = (LAS float*)(F.lds + 64 * RPB); LAS float* CE = CS + 32;
    LAS unsigned char* STG = F.lds + 64 * RPB + 256 + F.wave * 2048;
    static_assert(64 * RPB + 256 + 8 * 2048 <= LDSCTL_OFF, "router LDS");
    LAS int* CNT = (LAS int*)(F.lds + L_CNT); LAS int* BASE = (LAS int*)(F.lds + L_BASE); LAS unsigned* ASG = (LAS unsigned*)(F.lds + L_ASG);
    const float* g1 = inptr(IN_LN1G) + l * D; const float* b1 = inptr(IN_LN1B) + l * D;
    bf16* XB = (bf16*)(F.ws + WS_XB);
    unsigned* gcnt = (unsigned*)(F.ws + WS_CTL) + CW_CNT + l * 2048;
    unsigned* TOKINFO = (unsigned*)(F.ws + WS_TOKINFO); float* GATE = (float*)(F.ws + WS_GATE); int* TOKLIST = (int*)(F.ws + WS_TOKLIST);
    const int lane = F.lane, w = F.wave, r = lane & 31, h = lane >> 5;
    __syncthreads();
    for (int i = F.tid; i < 2 * NE * 128; i += 512) { const int row = i >> 7, c16 = i & 127;
        *(LAS u32x4*)(F.lds + row * RPB + c16 * 16) = *(const GAS u32x4*)(F.ws + WS_RIMG + (size_t)row * 2048 + c16 * 16); }
    if (F.tid < 64) CS[F.tid] = ((const GAS float*)(F.ws + WS_RIMG + 2 * NE * D * 2))[F.tid];
    f32x4 gg[4], bb[4];
#pragma unroll
    for (int j = 0; j < 4; ++j) { gg[j] = *(const GAS f32x4*)(g1 + 4 * lane + 256 * j); bb[j] = *(const GAS f32x4*)(b1 + 4 * lane + 256 * j); }
    for (int rbk = F.bid; rbk < T / 256; rbk += F.G) {
        if (F.tid < 32) CNT[F.tid] = 0;
        __syncthreads();
        const int tok0 = rbk * 256 + w * 32;
        const bf16* src = XB + (size_t)(tok0 + (lane >> 2)) * D + 8 * (lane & 3);
        u32x4 c0 = *(const GAS u32x4*)src, c1 = *(const GAS u32x4*)(src + 16 * D);
        f32x16 acc = zero16(), acc1 = zero16();
        float s1 = 0.f, s2 = 0.f;
#pragma unroll 2
        for (int ch = 0; ch < 32; ++ch) {
            u32x4 n0 = c0, n1 = c1;
            if (ch + 1 < 32) { n0 = *(const GAS u32x4*)(src + 32 * (ch + 1)); n1 = *(const GAS u32x4*)(src + 16 * D + 32 * (ch + 1)); }
            *(LAS u32x4*)(STG + lane * 16) = c0; *(LAS u32x4*)(STG + 1024 + lane * 16) = c1;
#pragma unroll
            for (int ks = 0; ks < 2; ++ks) { const u32x4 q = *(const LAS u32x4*)(STG + r * 64 + (2 * ks + h) * 16);
                const float x0 = bflo(q.x), x1 = bfhi(q.x), x2 = bflo(q.y), x3 = bfhi(q.y), x4 = bflo(q.z), x5 = bfhi(q.z), x6 = bflo(q.w), x7 = bfhi(q.w);
                s1 += ((x0 + x1) + (x2 + x3)) + ((x4 + x5) + (x6 + x7)); s2 += ((x0 * x0 + x1 * x1) + (x2 * x2 + x3 * x3)) + ((x4 * x4 + x5 * x5) + (x6 * x6 + x7 * x7));
                const int kcol = 32 * ch + 16 * ks + 8 * h;
                const bf16x8 af = __builtin_bit_cast(bf16x8, q);
                const bf16x8 bh = *(const LAS bf16x8*)(RWH + r * RPB + kcol * 2), bl = *(const LAS bf16x8*)(RWL + r * RPB + kcol * 2);
                acc = MFMA32(af, bh, acc); acc1 = MFMA32(af, bl, acc1); }
            asm volatile("s_waitcnt lgkmcnt(0)" ::: "memory");
            c0 = n0; c1 = n1;
        }
        s1 += shx(s1, 32, lane); s2 += shx(s2, 32, lane);
        const float mean = s1 * (1.f / D); const float rstd = rsqrtf(fmaxf(s2 * (1.f / D) - mean * mean, 0.f) + LN_EPS);
        const float cse = CS[r], cee = CE[r];
        unsigned key[16];
#pragma unroll
        for (int i = 0; i < 16; ++i) { const int rowi = crow(i, h); const float mi = shl(mean, rowi), ri = shl(rstd, rowi);
            const float lg = ri * ((acc[i] + acc1[i]) - mi * cse) + cee;
            const unsigned u = __float_as_uint(lg); const unsigned m = (u & 0x80000000u) ? ~u : (u | 0x80000000u); key[i] = (m & ~31u) | (unsigned)(31 - r); }
#pragma unroll
        for (int i = 0; i < 16; ++i) {
            unsigned mk[4];
#pragma unroll
            for (int k = 0; k < 4; ++k) { mk[k] = half_maxu(key[i], h); key[i] = (key[i] == mk[k]) ? 0u : key[i]; }
            float tv[4]; int te[4];
#pragma unroll
            for (int k = 0; k < 4; ++k) { te[k] = 31 - (int)(mk[k] & 31u); const unsigned m = mk[k] & ~31u; tv[k] = __uint_as_float((m & 0x80000000u) ? (m & 0x7fffffffu) : ~m); }
            const float e1 = __expf(tv[1] - tv[0]), e2 = __expf(tv[2] - tv[0]), e3 = __expf(tv[3] - tv[0]); const float isum = __builtin_amdgcn_rcpf(1.0f + e1 + e2 + e3);
            if (r < 4) { const int e = (r == 0) ? te[0] : ((r == 1) ? te[1] : ((r == 2) ? te[2] : te[3]));
                const float gt = ((r == 0) ? 1.0f : ((r == 1) ? e1 : ((r == 2) ? e2 : e3))) * isum;
                const int rowl = w * 32 + crow(i, h);
                const int rank = __hip_atomic_fetch_add(CNT + e, 1, __ATOMIC_RELAXED, __HIP_MEMORY_SCOPE_WORKGROUP);
                ASG[rowl * 4 + r] = ((unsigned)e << 24) | (unsigned)rank; GATE[(size_t)(rbk * 256 + rowl) * 4 + r] = gt; }
        }
        if (h == 0) *(GAS f32x2*)(F.ws + WS_STAT + (size_t)(tok0 + r) * 8) = (f32x2){mean, rstd};
#pragma unroll 2
        for (int rr = 0; rr < 32; ++rr) { const int tok = tok0 + rr;
            const float mr = __builtin_bit_cast(float, __builtin_amdgcn_readlane(__builtin_bit_cast(int, mean), rr)), sr = __builtin_bit_cast(float, __builtin_amdgcn_readlane(__builtin_bit_cast(int, rstd), rr));
            const u32x2* xb = (const u32x2*)(XB + (size_t)tok * D) + lane; unsigned* x8 = (unsigned*)(F.ws + WS_XB8 + (size_t)tok * D) + lane;
            u32x2 q[4];
#pragma unroll
            for (int j = 0; j < 4; ++j) q[j] = xb[64 * j];
#pragma unroll
            for (int j = 0; j < 4; ++j) { f32x4 v = (f32x4){bflo(q[j].x), bfhi(q[j].x), bflo(q[j].y), bfhi(q[j].y)}; v = (v - mr) * sr * gg[j] + bb[j];
                x8[64 * j] = pk4_fp8(v[0], v[1], v[2], v[3]); } }
        __syncthreads();
        if (F.tid < 32) BASE[F.tid] = (int)__hip_atomic_fetch_add(gcnt + F.tid * 64, (unsigned)CNT[F.tid], RLX_AGENT);
        __syncthreads();
        for (int idx = F.tid; idx < 1024; idx += 512) { const unsigned as = ASG[idx]; const int e = as >> 24; const int pos = BASE[e] + (int)(as & 0xffffffu); const int tokl = rbk * 256 + (idx >> 2);
            TOKINFO[(size_t)tokl * 4 + (idx & 3)] = ((unsigned)e << 24) | (unsigned)pos; TOKLIST[(size_t)e * T + pos] = tokl; }
        __syncthreads();
    }
}
DI int build_tiles(Frame& F, int l) {
    unsigned* gcnt = (unsigned*)(F.ws + WS_CTL) + CW_CNT + l * 2048;
    LAS int* CNT = (LAS int*)(F.lds + L_CNT); LAS int* TSTART = (LAS int*)(F.lds + L_TSTART);
    __syncthreads();
    if (F.tid < 32) CNT[F.tid] = (int)__hip_atomic_load(gcnt + F.tid * 64, RLX_AGENT);
    __syncthreads();
    if (F.tid == 0) { int acc = 0; for (int e = 0; e < NE; ++e) { TSTART[e] = acc; acc += (CNT[e] + 255) >> 8; } TSTART[NE] = acc; }
    __syncthreads();
    return TSTART[NE];
}
DI void phase_combine(Frame& F, const Args& a, int l) {
    (void)build_tiles(F, l);
    LAS int* TSTART = (LAS int*)(F.lds + L_TSTART);
    const float* g2 = inptr(IN_LN2G) + l * D; const float* b2 = inptr(IN_LN2B) + l * D;
    bf16* XB = (bf16*)(F.ws + WS_XB); const unsigned char* YS = (const unsigned char*)(F.ws + WS_YS);
    const unsigned* TOKINFO = (const unsigned*)(F.ws + WS_TOKINFO); const float* GATE = (const float*)(F.ws + WS_GATE);
    const int lane = F.lane;
    f32x4 gg[4], bb[4], g1a[4], b1a[4];
#pragma unroll
    for (int j = 0; j < 4; ++j) { gg[j] = *(const GAS f32x4*)(g2 + 4 * lane + 256 * j); bb[j] = *(const GAS f32x4*)(b2 + 4 * lane + 256 * j);
        g1a[j] = *(const GAS f32x4*)(inptr(IN_LN1G) + l * D + 4 * lane + 256 * j) * ALPHA; b1a[j] = *(const GAS f32x4*)(inptr(IN_LN1B) + l * D + 4 * lane + 256 * j) * ALPHA; }
    const float* STAT = (const float*)(F.ws + WS_STAT);
    const int stride = F.G * 8 * 2;
    int tok = (F.bid * 8 + F.wave) * 2;
    u32x4 tiN[2]; f32x4 gtN[2]; f32x4 stN;
#pragma unroll
    for (int q = 0; q < 2; ++q) { tiN[q] = *(const GAS u32x4*)(TOKINFO + (size_t)(tok + q) * 4); gtN[q] = *(const GAS f32x4*)(GATE + (size_t)(tok + q) * 4); }
    stN = *(const GAS f32x4*)(STAT + (size_t)tok * 2);
    for (; tok < T; tok += stride) {
        u32x4 ti[2]; f32x4 gt[2]; const f32x4 st = stN;
#pragma unroll
        for (int q = 0; q < 2; ++q) { ti[q] = tiN[q]; gt[q] = gtN[q]; }
        u32x2 xq[2][4]; unsigned yq[2][4][4];
#pragma unroll
        for (int q = 0; q < 2; ++q) { const u32x2* xb = (const u32x2*)(XB + (size_t)(tok + q) * D) + lane;
#pragma unroll
            for (int j = 0; j < 4; ++j) xq[q][j] = xb[64 * j];
#pragma unroll
            for (int k = 0; k < 4; ++k) { const unsigned inf = (k == 0) ? ti[q].x : ((k == 1) ? ti[q].y : ((k == 2) ? ti[q].z : ti[q].w));
                const int e = inf >> 24, pos = inf & 0xffffffu; const size_t slot = (size_t)TSTART[e] * 256 + pos;
                const unsigned* yr = (const unsigned*)(YS + slot * D) + lane;
#pragma unroll
                for (int j = 0; j < 4; ++j) yq[q][k][j] = yr[64 * j]; } }
        if (tok + stride < T) {
#pragma unroll
            for (int q = 0; q < 2; ++q) { tiN[q] = *(const GAS u32x4*)(TOKINFO + (size_t)(tok + stride + q) * 4); gtN[q] = *(const GAS f32x4*)(GATE + (size_t)(tok + stride + q) * 4); }
            stN = *(const GAS f32x4*)(STAT + (size_t)(tok + stride) * 2); }
#pragma unroll
        for (int q = 0; q < 2; ++q) {
            f32x4 v[4];
#pragma unroll
            for (int j = 0; j < 4; ++j) { const float sr = st[2 * q + 1], mr = -st[2 * q] * sr;
                f32x4 z = (f32x4){bflo(xq[q][j].x), bfhi(xq[q][j].x), bflo(xq[q][j].y), bfhi(xq[q][j].y)}; z = z * sr + mr; v[j] = z * g1a[j] + b1a[j]; }
#pragma unroll
            for (int k = 0; k < 4; ++k) { const float gk = gt[q][k] * 0.0625f;
#pragma unroll
                for (int j = 0; j < 4; ++j) { const f32x2 ylo = __builtin_amdgcn_cvt_pk_f32_fp8((int)yq[q][k][j], false), yhi = __builtin_amdgcn_cvt_pk_f32_fp8((int)yq[q][k][j], true);
                    v[j][0] += gk * ylo[0]; v[j][1] += gk * ylo[1]; v[j][2] += gk * yhi[0]; v[j][3] += gk * yhi[1]; } }
            float sm = 0.f;
#pragma unroll
            for (int j = 0; j < 4; ++j) sm += (v[j][0] + v[j][1]) + (v[j][2] + v[j][3]);
            const float mean = wave_sum(sm) * (1.f / D); float s2 = 0.f;
#pragma unroll
            for (int j = 0; j < 4; ++j) { v[j] = v[j] - mean; s2 += (v[j][0] * v[j][0] + v[j][1] * v[j][1]) + (v[j][2] * v[j][2] + v[j][3] * v[j][3]); }
            const float rstd = rsqrtf(wave_sum(s2) * (1.f / D) + LN_EPS);
            if (l == DEPTH - 1) { f32x4* xr = (f32x4*)(F.out + (size_t)(tok + q) * D) + lane;
#pragma unroll
                for (int j = 0; j < 4; ++j) xr[64 * j] = v[j] * rstd * gg[j] + bb[j]; }
            else { u32x2* xb = (u32x2*)(XB + (size_t)(tok + q) * D) + lane;
#pragma unroll
                for (int j = 0; j < 4; ++j) { v[j] = v[j] * rstd * gg[j] + bb[j]; u32x2 o; o.x = pk2(v[j][0], v[j][1]); o.y = pk2(v[j][2], v[j][3]); xb[64 * j] = o;
                    ((unsigned*)(F.ws + WS_XI8 + (size_t)(tok + q) * D))[lane + 64 * j] = pk4_fp8(v[j][0], v[j][1], v[j][2], v[j][3]); } }
        }
    }
}

constexpr int PH_PER_LAYER = 10, N_PHASES = DEPTH * PH_PER_LAYER;
__global__ void __launch_bounds__(512, 2) fwd_kernel(Args args) {
    extern __shared__ __attribute__((aligned(16))) unsigned char lds_raw[];
    Frame F0;
    F0.lds = (LAS unsigned char*)lds_raw;
    F0.tid = threadIdx.x; F0.lane = F0.tid & 63; F0.wave = __builtin_amdgcn_readfirstlane(F0.tid >> 6);
    F0.G = gridDim.x; F0.bid = blockIdx.x; F0.ws = args.ws; F0.out = args.out;
    volatile LAS unsigned* BARST = (volatile LAS unsigned*)(F0.lds + L_BARST);
    for (int u = F0.tid; u < (LDS_BYTES - LDSCTL_OFF) / 4; u += 512) ((LAS unsigned*)(F0.lds + LDSCTL_OFF))[u] = 0u;
    __syncthreads();
    unsigned* ctl = (unsigned*)(F0.ws + WS_CTL);
    XcdBarrier bar; bar.bar = ctl + CW_BAR; bar.x = 0; bar.st = nullptr;
    if (args.one_launch) bar = xcd_barrier_post(ctl + CW_BAR, BARST, F0.wave);
    const int lo = args.ph_lo, hi = args.ph_hi;
#define IN(k) (lo <= (k) && (k) < hi)
#define ENTER() Frame F = F0; asm volatile("" : "+s"(F.wave), "+s"(F.bid), "+s"(F.G), "+s"(F.ws), "+s"(F.out)); { unsigned z_ = 0u; asm volatile("" : "+v"(z_)); F.lane = (int)__builtin_amdgcn_mbcnt_hi(~0u, __builtin_amdgcn_mbcnt_lo(~0u, z_)); } F.tid = F.wave * 64 + F.lane; F.ws = (unsigned char*)(GAS unsigned char*)F.ws; F.out = (float*)(GAS float*)F.out; bf16* P = (bf16*)(F.ws + WS_R); (void)P
#define SEAM(k) do { if (IN(k) && IN((k) + 1)) xcd_barrier(bar, F0.wave); } while (0)
#pragma unroll
    for (int l = 0; l < DEPTH; ++l) {
        const int pb = l * PH_PER_LAYER;
        if (l == 0) {
            if (IN(pb + 0)) { ENTER(); phase_weights(F, args, l); }
            SEAM(pb + 0);
        }
        if (IN(pb + 1)) { ENTER();
            pg8::DenseSched S; S.init((const bf16*)(F.ws + WS_XI8), D, (const bf16*)(F.ws + WS_WIN), T, IN_COLS, D, F.G, F.bid, 1, 0x7F7F7F7F, 0x7A7A7A7A);
            pg8::EpiInProj E{P, (const float*)(F.ws + WS_ROPE)};
            pg8::gemm_phase<pg8::EpiInProj, pg8::DenseSched, false, true>(F.lds, F.tid, S, E);
        }
        SEAM(pb + 1);
        if (IN(pb + 2)) { ENTER(); phase_attn(F, args, l); }
        SEAM(pb + 2);
        if (IN(pb + 3)) { ENTER(); phase_scan(F, args, l); }
        SEAM(pb + 3);
        if (IN(pb + 4)) { ENTER();
            pg8::DualSched S; S.init(F.ws + WS_ATT8, 0x7B7B7B7B, F.ws + WS_WAO, F.ws + WS_RWO, 0x7D7D7D7D, F.ws + WS_WRO, D, T, D, D, F.G, F.bid, 0x7A7A7A7A);
            pg8::EpiDual E{F.ws + WS_M8, P + C_GA, P + C_GR};
            pg8::gemm_phase<pg8::EpiDual, pg8::DualSched, false, true>(F.lds, F.tid, S, E);
        }
        SEAM(pb + 4);
        if (IN(pb + 5)) { ENTER();
            pg8::DenseSched S; S.init((const bf16*)(F.ws + WS_M8), D, (const bf16*)(F.ws + WS_WOUT), T, D, D, F.G, F.bid, 1, 0x7B7B7B7B, 0x7A7A7A7A);
            pg8::EpiResid E{(bf16*)(F.ws + WS_XB), (l == 0) ? inptr(IN_X) : (const float*)nullptr};
            pg8::gemm_phase<pg8::EpiResid, pg8::DenseSched, false, true>(F.lds, F.tid, S, E);
        }
        SEAM(pb + 5);
        if (IN(pb + 6)) { ENTER(); phase_router(F, args, l); }
        SEAM(pb + 6);
        if (IN(pb + 7)) { ENTER();
            const int NT = build_tiles(F, l);
            pg8::MoeSched S; S.A = (const bf16*)(F.ws + WS_XB8); S.Bt = (const bf16*)(F.ws + WS_W1); S.lda = D; S.K = D; S.npn = 8; S.NT = NT; S.nwg = NT * 8; S.G = F.G; S.c = F.bid; S.bexp = (size_t)2048 * 1024;
            S.tstart = (const LAS int*)(F.lds + L_TSTART); S.cnt = (const LAS int*)(F.lds + L_CNT); S.toklist = (const int*)(F.ws + WS_TOKLIST); S.gather = true;
            S.eb = 1; S.sA = 0x7F7F7F7F; S.sB = 0x7A7A7A7A;
            pg8::EpiSwiglu E{(bf16*)(F.ws + WS_ACT), inptr(IN_EB1) + (size_t)l * NE * 2048};
            pg8::gemm_phase<pg8::EpiSwiglu, pg8::MoeSched, true, true>(F.lds, F.tid, S, E);
        }
        SEAM(pb + 7);
        if (IN(pb + 8)) { ENTER();
            const int NT = build_tiles(F, l);
            pg8::MoeSched S; S.A = (const bf16*)(F.ws + WS_ACT); S.Bt = (const bf16*)(F.ws + WS_W2); S.lda = DE; S.K = DE; S.npn = 4; S.NT = NT; S.nwg = NT * 4; S.G = F.G; S.c = F.bid; S.bexp = (size_t)1024 * 1024;
            S.tstart = (const LAS int*)(F.lds + L_TSTART); S.cnt = (const LAS int*)(F.lds + L_CNT); S.toklist = (const int*)(F.ws + WS_TOKLIST); S.gather = false; S.eb = 1; S.sA = 0x7D7D7D7D; S.sB = 0x79797979;
            pg8::EpiYs E{(unsigned char*)(F.ws + WS_YS), inptr(IN_EB2) + (size_t)l * NE * 1024};
            pg8::gemm_phase<pg8::EpiYs, pg8::MoeSched, false, true>(F.lds, F.tid, S, E);
        }
        SEAM(pb + 8);
        if (IN(pb + 9)) { { ENTER(); phase_combine(F, args, l); } if (l + 1 < DEPTH) { ENTER(); phase_weights(F, args, l + 1); } }
        SEAM(pb + 9);
    }
#undef IN
#undef SEAM
#undef ENTER
}

extern "C" void kernel_launch(void* const* d_in, const int* in_sizes, int n_in, void* d_out, int out_size, void* d_ws, size_t ws_size, hipStream_t stream) {
    static int grid = 0;
    if (grid == 0) {
        if (n_in != 30 || out_size != T * D || ws_size < WS_END) { fprintf(stderr, "kernel_launch: unexpected problem (n_in %d, out %d, ws %zu)\n", n_in, out_size, ws_size); grid = -1; return; }
        int dev = 0, cus = 0;
        if (hipGetDevice(&dev) != hipSuccess || hipDeviceGetAttribute(&cus, hipDeviceAttributeMultiprocessorCount, dev) != hipSuccess) { grid = -1; return; }
        if (hipFuncSetAttribute((const void*)fwd_kernel, hipFuncAttributeMaxDynamicSharedMemorySize, LDS_BYTES) != hipSuccess) { fprintf(stderr, "kernel_launch: hipFuncSetAttribute failed\n"); grid = -1; return; }
        int per_cu = 0;
        if (hipOccupancyMaxActiveBlocksPerMultiprocessor(&per_cu, (const void*)fwd_kernel, 512, LDS_BYTES) != hipSuccess || per_cu < 1) fprintf(stderr, "kernel_launch: occupancy query reports %d\n", per_cu);
        (void)hipGetLastError();
        grid = cus;
    }
    if (grid < 0) return;
    (void)hipMemsetAsync((char*)d_ws + WS_CTL, 0, CTL_ZERO_BYTES, stream);
    Args a{};
    for (int i = 0; i < 30; ++i) a.in[i] = (const float*)d_in[i];
    a.out = (float*)d_out; a.ws = (unsigned char*)d_ws; a.pad = 0;
#if MK_ONE_LAUNCH
    a.ph_lo = 0; a.ph_hi = N_PHASES; a.one_launch = 1;
    hipLaunchKernelGGL(fwd_kernel, dim3(grid), dim3(512), LDS_BYTES, stream, a);
#else
    for (int p = 0; p < N_PHASES; ++p) { a.ph_lo = p; a.ph_hi = p + 1; a.one_launch = 0; hipLaunchKernelGGL(fwd_kernel, dim3(grid), dim3(512), LDS_BYTES, stream, a); }
#endif
}
```
